# Optimizing an MI355X kernel written in HIP

```python
import math
import jax, jax.numpy as jnp
from jax import lax
import numpy as np


D_MODEL = 4096
BATCH = 4
SEQ = 4096
DEPTH = 1

N_META = 16
ATT_HEADS = D_MODEL // 256
HEAD_DIM = 128
ATT_WIDTH = ATT_HEADS * HEAD_DIM
Q_BLOCK = 128
SSM_GROUP_CH = 16
SSM_GROUPS = D_MODEL // 32
SSM_WIDTH = SSM_GROUPS * SSM_GROUP_CH
SSM_STATE = 64
PEER_HEADS = 8
PEER_KEYS = 128
PEER_N = PEER_KEYS * PEER_KEYS
PEER_TOPK = 16
PEER_KEY_DIM = 256
PEER_HALF = PEER_KEY_DIM // 2
PEER_CHUNK = 16
EPS = 1e-6

COL_Q = 0
COL_K = COL_Q + ATT_WIDTH
COL_V = COL_K + ATT_WIDTH
COL_F = COL_V + ATT_WIDTH
COL_U = COL_F + ATT_HEADS
COL_GA = COL_U + SSM_WIDTH
COL_GB = COL_GA + D_MODEL
N_COLS = COL_GB + D_MODEL

kernel_name = 'hybrid_fox_s5_peer_block'


def rmsnorm(x, g):
    xf = x.astype(jnp.float32)
    y = xf * lax.rsqrt(jnp.mean(xf * xf, axis=-1, keepdims=True) + EPS) * g.astype(jnp.float32)
    return y.astype(x.dtype)


def forgetting_attention(q, k, v, logf):
    L = q.shape[1]
    scale = 1.0 / math.sqrt(HEAD_DIM)
    c = jnp.swapaxes(jnp.cumsum(logf, axis=1), 1, 2)
    n_blocks = (L - N_META) // Q_BLOCK
    bounds = [(0, N_META)] + [(N_META + i * Q_BLOCK, N_META + (i + 1) * Q_BLOCK) for i in range(n_blocks)]
    outs = []
    for s0, s1 in bounds:
        qb = q[:, s0:s1]
        kb = k[:, :s1]
        vb = v[:, :s1]
        logits = jnp.einsum('bqhd,bkhd->bhqk', qb, kb, preferred_element_type=jnp.float32) * scale
        logits = logits + (c[:, :, s0:s1, None] - c[:, :, None, :s1])
        mask = (s0 + jnp.arange(s1 - s0))[:, None] >= jnp.arange(s1)[None, :]
        logits = jnp.where(mask, logits, -jnp.inf)
        p = jax.nn.softmax(logits, axis=-1)
        outs.append(jnp.einsum('bhqk,bkhd->bqhd', p.astype(vb.dtype), vb))
    return jnp.concatenate(outs, axis=1)


def s5_branch(u, lam_re, lam_im, log_dt, b_re, b_im, c_re, c_im, d_skip, w_glu):
    Bb, L, _ = u.shape
    f32 = jnp.float32
    uf = u.astype(f32).reshape(Bb, L, SSM_GROUPS, SSM_GROUP_CH)
    dt = jnp.exp(log_dt.astype(f32))[:, None]
    lr = lam_re.astype(f32)
    li = lam_im.astype(f32)
    mag = jnp.exp(lr * dt)
    ar = mag * jnp.cos(li * dt)
    ai = mag * jnp.sin(li * dt)
    nr = ar - 1.0
    den = lr * lr + li * li
    fr = (nr * lr + ai * li) / den
    fi = (ai * lr - nr * li) / den
    br = b_re.astype(f32)
    bi = b_im.astype(f32)
    bbr = fr[..., None] * br - fi[..., None] * bi
    bbi = fr[..., None] * bi + fi[..., None] * br
    xr = jnp.einsum('blgc,gpc->blgp', uf, bbr)
    xi = jnp.einsum('blgc,gpc->blgp', uf, bbi)
    a_r = jnp.broadcast_to(ar, (1, L, SSM_GROUPS, SSM_STATE))
    a_i = jnp.broadcast_to(ai, (1, L, SSM_GROUPS, SSM_STATE))

    def combine(e1, e2):
        a1r, a1i, b1r, b1i = e1
        a2r, a2i, b2r, b2i = e2
        return (a1r * a2r - a1i * a2i,
                a1r * a2i + a1i * a2r,
                a2r * b1r - a2i * b1i + b2r,
                a2r * b1i + a2i * b1r + b2i)

    _, _, sr, si = lax.associative_scan(combine, (a_r, a_i, xr, xi), axis=1)
    y = (jnp.einsum('blgp,gcp->blgc', sr, c_re.astype(f32))
         - jnp.einsum('blgp,gcp->blgc', si, c_im.astype(f32))
         + d_skip.astype(f32) * uf)
    z = jax.nn.gelu(y.reshape(Bb, L, SSM_WIDTH))
    out = z * jax.nn.sigmoid(z @ w_glu.astype(f32))
    return out.astype(u.dtype)


def token_mixing(hn, w_in, b_forget, q_norm_g, k_norm_g, lam_re, lam_im, log_dt,
                 b_re, b_im, c_re, c_im, d_skip, w_glu, w_branch_attn, w_branch_ssm, w_out):
    Bb, L, _ = hn.shape
    proj = hn @ w_in
    q = rmsnorm(proj[..., COL_Q:COL_K].reshape(Bb, L, ATT_HEADS, HEAD_DIM), q_norm_g)
    k = rmsnorm(proj[..., COL_K:COL_V].reshape(Bb, L, ATT_HEADS, HEAD_DIM), k_norm_g)
    v = proj[..., COL_V:COL_F].reshape(Bb, L, ATT_HEADS, HEAD_DIM)
    logf = jax.nn.log_sigmoid((proj[..., COL_F:COL_U] + b_forget).astype(jnp.float32))
    attn = forgetting_attention(q, k, v, logf).reshape(Bb, L, ATT_WIDTH)
    ssm = s5_branch(proj[..., COL_U:COL_GA], lam_re, lam_im, log_dt, b_re, b_im,
                    c_re, c_im, d_skip, w_glu)
    g_a = jax.nn.sigmoid(proj[..., COL_GA:COL_GB])
    g_b = jax.nn.sigmoid(proj[..., COL_GB:N_COLS])
    mix = g_a * (attn @ w_branch_attn) + g_b * (ssm @ w_branch_ssm)
    return mix @ w_out


def peer_ffn(hn, w_query, sub_keys, expert_u, expert_v):
    Bb, L, D = hn.shape
    T = Bb * L
    xt = hn.reshape(T, D)
    q = (xt @ w_query).reshape(T, PEER_HEADS, 2, PEER_HALF)
    s = jnp.einsum('thcd,cnd->thcn', q, sub_keys, preferred_element_type=jnp.float32)
    sv, si = lax.top_k(s, PEER_TOPK)
    cand = (sv[:, :, 0, :, None] + sv[:, :, 1, None, :]).reshape(T, PEER_HEADS, PEER_TOPK * PEER_TOPK)
    best, pos = lax.top_k(cand, PEER_TOPK)
    i1 = jnp.take_along_axis(si[:, :, 0], pos // PEER_TOPK, axis=-1)
    i2 = jnp.take_along_axis(si[:, :, 1], pos % PEER_TOPK, axis=-1)
    experts = i1 * PEER_KEYS + i2
    gates = jax.nn.softmax(best, axis=-1)
    n_chunks = T // PEER_CHUNK

    def chunk(args):
        xc, ec, gc = args
        u = jnp.take(expert_u, ec, axis=0)
        a = jnp.einsum('cd,chkd->chk', xc, u, preferred_element_type=jnp.float32)
        w = (gc * jax.nn.gelu(a)).astype(xc.dtype)
        vv = jnp.take(expert_v, ec, axis=0)
        return jnp.einsum('chk,chkd->cd', w, vv)

    y = lax.map(chunk, (xt.reshape(n_chunks, PEER_CHUNK, D),
                        experts.reshape(n_chunks, PEER_CHUNK, PEER_HEADS, PEER_TOPK),
                        gates.reshape(n_chunks, PEER_CHUNK, PEER_HEADS, PEER_TOPK)))
    return y.reshape(Bb, L, D)


def setup_inputs(seed: int = 0) -> dict:
    key = jax.random.key(seed)
    ks = jax.random.split(key, 24)
    f32 = jnp.float32
    nrm = lambda k, shp, s: jax.random.normal(k, shp, f32) * s
    lam_im_base = math.pi * jnp.arange(SSM_STATE, dtype=f32)
    return {
        'x': nrm(ks[0], (BATCH, SEQ, D_MODEL), 1.0),
        'meta_tokens': nrm(ks[1], (N_META, D_MODEL), 1.0),
        'norm1_g': 1.0 + nrm(ks[2], (DEPTH, D_MODEL), 0.02),
        'w_in': nrm(ks[3], (DEPTH, D_MODEL, N_COLS), D_MODEL ** -0.5),
        'b_forget': 3.0 + nrm(ks[4], (DEPTH, ATT_HEADS), 0.5),
        'q_norm_g': 1.0 + nrm(ks[5], (DEPTH, HEAD_DIM), 0.02),
        'k_norm_g': 1.0 + nrm(ks[6], (DEPTH, HEAD_DIM), 0.02),
        'lam_re': -0.5 + nrm(ks[7], (DEPTH, SSM_GROUPS, SSM_STATE), 0.01),
        'lam_im': lam_im_base + nrm(ks[8], (DEPTH, SSM_GROUPS, SSM_STATE), 0.01),
        'log_dt': jax.random.uniform(ks[9], (DEPTH, SSM_GROUPS), f32, math.log(1e-3), math.log(1e-1)),
        'b_re': nrm(ks[10], (DEPTH, SSM_GROUPS, SSM_STATE, SSM_GROUP_CH), (2 * SSM_GROUP_CH) ** -0.5),
        'b_im': nrm(ks[11], (DEPTH, SSM_GROUPS, SSM_STATE, SSM_GROUP_CH), (2 * SSM_GROUP_CH) ** -0.5),
        'c_re': nrm(ks[12], (DEPTH, SSM_GROUPS, SSM_GROUP_CH, SSM_STATE), SSM_STATE ** -0.5),
        'c_im': nrm(ks[13], (DEPTH, SSM_GROUPS, SSM_GROUP_CH, SSM_STATE), SSM_STATE ** -0.5),
        'd_skip': 1.0 + nrm(ks[14], (DEPTH, SSM_GROUPS, SSM_GROUP_CH), 0.1),
        'w_glu': nrm(ks[15], (DEPTH, SSM_WIDTH, SSM_WIDTH), SSM_WIDTH ** -0.5),
        'w_branch_attn': nrm(ks[16], (DEPTH, ATT_WIDTH, D_MODEL), ATT_WIDTH ** -0.5),
        'w_branch_ssm': nrm(ks[17], (DEPTH, SSM_WIDTH, D_MODEL), SSM_WIDTH ** -0.5),
        'w_out': nrm(ks[18], (DEPTH, D_MODEL, D_MODEL), D_MODEL ** -0.5),
        'norm2_g': 1.0 + nrm(ks[19], (DEPTH, D_MODEL), 0.02),
        'w_query': nrm(ks[20], (DEPTH, D_MODEL, PEER_HEADS * PEER_KEY_DIM), D_MODEL ** -0.5),
        'sub_keys': nrm(ks[21], (DEPTH, 2, PEER_KEYS, PEER_HALF), PEER_HALF ** -0.5),
        'expert_u': nrm(ks[22], (DEPTH, PEER_N, D_MODEL), D_MODEL ** -0.5),
        'expert_v': nrm(ks[23], (DEPTH, PEER_N, D_MODEL), (PEER_HEADS * PEER_TOPK) ** -0.5),
    }


def reference(x, meta_tokens, norm1_g, w_in, b_forget, q_norm_g, k_norm_g, lam_re, lam_im,
              log_dt, b_re, b_im, c_re, c_im, d_skip, w_glu, w_branch_attn, w_branch_ssm,
              w_out, norm2_g, w_query, sub_keys, expert_u, expert_v):
    Bb = x.shape[0]
    meta = jnp.broadcast_to(meta_tokens[None].astype(x.dtype), (Bb, N_META, x.shape[-1]))
    h = jnp.concatenate([meta, x], axis=1)
    for layer in range(DEPTH):
        h = h + token_mixing(rmsnorm(h, norm1_g[layer]), w_in[layer], b_forget[layer],
                             q_norm_g[layer], k_norm_g[layer], lam_re[layer], lam_im[layer],
                             log_dt[layer], b_re[layer], b_im[layer], c_re[layer], c_im[layer],
                             d_skip[layer], w_glu[layer], w_branch_attn[layer],
                             w_branch_ssm[layer], w_out[layer])
        h = h + peer_ffn(rmsnorm(h, norm2_g[layer]), w_query[layer], sub_keys[layer],
                         expert_u[layer], expert_v[layer])
    return h[:, N_META:]
```

```cpp
#include <hip/hip_runtime.h>
#include <cstdio>
#include <cstdint>
#include <hip/hip_bf16.h>

#define GAS __attribute__((address_space(1)))
#define LAS __attribute__((address_space(3)))
typedef unsigned short bf16;
typedef unsigned short bf16_t;
typedef short bf16x8 __attribute__((ext_vector_type(8)));
typedef short s16x4 __attribute__((ext_vector_type(4)));
typedef float f32x2 __attribute__((ext_vector_type(2)));
typedef float f32x4 __attribute__((ext_vector_type(4)));
typedef float f32x16 __attribute__((ext_vector_type(16)));
typedef unsigned u32x2 __attribute__((ext_vector_type(2)));
typedef unsigned u32x4 __attribute__((ext_vector_type(4)));
typedef GAS unsigned gu32;

constexpr int NB = 4, SEQ = 4096, DM = 4096, NTOK = NB * SEQ;
constexpr int NMETA = 16, NROWS = NTOK + NMETA;
constexpr int NH = 16, HD = 128, ATTW = NH * HD;
constexpr int KVPAD = 64, SKV = KVPAD + SEQ;
constexpr int NG = 128, GC = 16, NS = 64, SSMW = NG * GC;
constexpr int NCOLS_SRC = 16400;
constexpr int C_Q = 0, C_K = 2048, C_V = 4096, C_U = 6144, C_GA = 8192, C_GB = 12288, C_F = 16384, NW1 = 16400;
constexpr int PEER_H = 8, PEER_K = 128, PEER_TOPK = 16, PEER_QW = 2048, PEER_N = 16384;
constexpr float EPS = 1e-6f;
constexpr int NCH = 8, LCH = SEQ / NCH;

constexpr size_t MiB = 1u << 20;
constexpr size_t WS_CTL = 0, CTL_ZERO_BYTES = 192 * 1024;
constexpr size_t WS_LOGF = 1 * MiB;
constexpr size_t WS_BIAS = 3 * MiB;
constexpr size_t WS_S5E  = 5 * MiB;
constexpr size_t WS_PSS  = 5 * MiB;
constexpr size_t WS_UMETA = 7 * MiB;
constexpr size_t WS_KT = 7 * MiB + 512 * 1024;
constexpr size_t WS_WT1 = 8 * MiB;
constexpr size_t WS_Z = 8 * MiB;
constexpr size_t WS_WGLU = 137 * MiB;
constexpr size_t WS_WAB = 145 * MiB;
constexpr size_t WS_WOUT = 177 * MiB;
constexpr size_t WS_WQ = 209 * MiB;
constexpr size_t WS_HN = 225 * MiB;
constexpr size_t WS_Q = 354 * MiB;
constexpr size_t WS_K = 418 * MiB;
constexpr size_t WS_V = 484 * MiB;
constexpr size_t WS_U = 549 * MiB;
constexpr size_t WS_GA = 677 * MiB;
constexpr size_t WS_GB = 805 * MiB;
constexpr size_t WS_AS = 933 * MiB;
constexpr size_t WS_E4 = 354 * MiB;
constexpr size_t E4ROW = 2176;
constexpr size_t WS_E4S = 418 * MiB;
constexpr size_t WS_S5T = 1061 * MiB;
constexpr size_t S5T_AT = 0, S5T_BFR = 64 * 1024, S5T_CFR = S5T_BFR + 1024 * 1024;
constexpr size_t WS_A8 = 1063 * MiB;
constexpr size_t WS_W8 = 1127 * MiB;
constexpr size_t WS_SA = 1191 * MiB;
constexpr size_t WS_SW = 1191 * MiB + 65536;
constexpr size_t WS_SA2 = 1191 * MiB + 131072;
constexpr size_t WS_SW2 = 1191 * MiB + 327680;
constexpr size_t WS_AS8 = 1063 * MiB;
constexpr size_t WS_MIX8 = 1127 * MiB;
constexpr size_t WS_END = 1192 * MiB;
constexpr int CW_CMAX2 = 32768;
constexpr int CW_CMAX = 16384;

#define LDS_WAIT() asm volatile("s_waitcnt lgkmcnt(0)" ::: "memory")
#define VM_WAIT() asm volatile("s_waitcnt vmcnt(0)" ::: "memory")
__device__ __forceinline__ unsigned f2bf(float f) { unsigned u = __builtin_bit_cast(unsigned, f); return (u + 0x7fffu + ((u >> 16) & 1u)) >> 16; }
typedef __bf16 bf16x2_t __attribute__((ext_vector_type(2)));
__device__ __forceinline__ unsigned pk2(float lo, float hi) { const f32x2 v = {lo, hi}; return __builtin_bit_cast(unsigned, __builtin_convertvector(v, bf16x2_t)); }
__device__ __forceinline__ float bflo(unsigned w) { return __builtin_bit_cast(float, w << 16); }
__device__ __forceinline__ float bfhi(unsigned w) { return __builtin_bit_cast(float, w & 0xffff0000u); }
__device__ __forceinline__ float wave_sum(float v) {
#pragma unroll
    for (int o = 1; o < 64; o <<= 1) v += __shfl_xor(v, o);
    return v;
}
__device__ __forceinline__ float sigmoidf_(float v) { return __builtin_amdgcn_rcpf(1.f + __expf(-v)); }
__device__ __forceinline__ float gelu_tanh(float x) { const float a = 1.5957691216057308f * (x + 0.044715f * x * x * x); return x * sigmoidf_(a); }
#define XB_TMO      128
#define XB_XCNT(j)  (256  + 64 * (j))
#define XB_XSUB(j)  (1280 + 64 * (j))
#define XB_XGEN(j)  (2304 + 64 * (j))
#define XB_TOP      3328
#define XB_TOPGEN   3392
#define XCD_BAR_WORDS 3456
#define XB_SPIN_CAP (1u << 18)

__device__ __forceinline__ unsigned xb_ld(unsigned* p)              { return __hip_atomic_load(p, __ATOMIC_RELAXED, __HIP_MEMORY_SCOPE_AGENT); }
__device__ __forceinline__ unsigned xb_add(unsigned* p, unsigned v) { return __hip_atomic_fetch_add(p, v, __ATOMIC_RELAXED, __HIP_MEMORY_SCOPE_AGENT); }
__device__ __forceinline__ unsigned xb_xcc_id() { return (unsigned)__builtin_amdgcn_s_getreg((3 << 11) | 20) & 0xFu; }
#define XB_SPIN(cond, bar) do { unsigned _sp = 0; while (cond) { __builtin_amdgcn_s_sleep(1); \
    if ((++_sp & 255u) == 0u) { if (xb_ld(&(bar)[XB_TMO])) break; if (_sp > XB_SPIN_CAP) { atomicAdd(&(bar)[XB_TMO], 1u); break; } } } } while (0)

struct XcdBarrier {
    unsigned* bar; unsigned x;
    volatile LAS unsigned* st;
};

__device__ __forceinline__ XcdBarrier xcd_barrier_post(unsigned* bar, volatile LAS unsigned* st) {
    XcdBarrier b; b.bar = bar; b.x = xb_xcc_id(); b.st = st;
    if (threadIdx.x == 0) (void)xb_add(&bar[XB_XCNT(b.x)], 1u);
    return b;
}
__device__ __forceinline__ void xcd_barrier_complete(unsigned* bar, unsigned x, unsigned& nloc, unsigned& nx) {
    const unsigned G = gridDim.x * gridDim.y * gridDim.z;
    unsigned sum, cnt, mine, sp = 0u;
    for (;;) {
        sum = 0u; cnt = 0u; mine = 0u;
#pragma unroll
        for (unsigned j = 0; j < 16; ++j) { const unsigned c = xb_ld(&bar[XB_XCNT(j)]); sum += c; cnt += (c > 0u) ? 1u : 0u; mine = (j == x) ? c : mine; }
        if (sum == G) break;
        __builtin_amdgcn_s_sleep(1);
        if ((++sp & 255u) == 0u) { if (xb_ld(&bar[XB_TMO])) break; if (sp > XB_SPIN_CAP) { atomicAdd(&bar[XB_TMO], 1u); break; } }
    }
    nloc = mine > 0u ? mine : 1u; nx = cnt > 0u ? cnt : 1u;
}

__device__ __forceinline__ void xcd_barrier(const XcdBarrier& b) {
    asm volatile("s_waitcnt vmcnt(0)" ::: "memory");
    __syncthreads();
    if (threadIdx.x == 0) {
        unsigned* bar = b.bar;
        __builtin_amdgcn_s_waitcnt(0);
        unsigned nloc = b.st[0], nx = b.st[1];
        if (nloc == 0u) { xcd_barrier_complete(bar, b.x, nloc, nx); b.st[0] = nloc; b.st[1] = nx; }
        const unsigned old = xb_add(&bar[XB_XSUB(b.x)], 1u);
        const unsigned gen = old / nloc;
        if (old + 1u == (gen + 1u) * nloc) {
            __builtin_amdgcn_fence(__ATOMIC_RELEASE, "agent");
            asm volatile("s_waitcnt vmcnt(0)" ::: "memory");
            const unsigned og = xb_add(&bar[XB_TOP], 1u);
            const unsigned tg = og / nx;
            if (og + 1u == (tg + 1u) * nx) xb_add(&bar[XB_TOPGEN], 1u);
            else XB_SPIN(xb_ld(&bar[XB_TOPGEN]) == tg, bar);
            __builtin_amdgcn_fence(__ATOMIC_ACQUIRE, "agent");
            xb_add(&bar[XB_XGEN(b.x)], 1u);
            asm volatile("s_waitcnt vmcnt(0)" ::: "memory");
        } else {
            XB_SPIN(xb_ld(&bar[XB_XGEN(b.x)]) == gen, bar);
            __builtin_amdgcn_fence(__ATOMIC_ACQUIRE, "agent");
            asm volatile("s_waitcnt vmcnt(0)" ::: "memory");
        }
    }
    __syncthreads();
}
namespace pg8 {
#define PG8_LAS __attribute__((address_space(3)))
constexpr int BM = 256, BK = 64, HALF = 128, HTB = HALF * BK * 2  , STAGE_BYTES = 8 * HTB, NXCD = 8, WGM = 8;
__host__ __device__ __forceinline__ int lds_byte(int r, int c) { const int st = (r >> 4) * 2 + (c >> 5), rr = r & 15, cc = c & 31, ob = rr * 64 + cc * 2; return st * 1024 + (ob ^ (((ob >> 9) & 1) << 5)); }
__host__ __device__ __forceinline__ void stage_rc(int b, int& R, int& C) { const int st = b / 1024, sb = b % 1024, swz = sb ^ (((sb >> 9) & 1) << 5); R = (st >> 1) * 16 + swz / 64; C = (st & 1) * 32 + (swz % 64) / 2; }
__host__ __device__ __forceinline__ int perm32(int rho) { const int n = rho >> 4, i = rho & 15; return 8 * (i >> 2) + 4 * n + (i & 3); }
typedef int i32x4g __attribute__((ext_vector_type(4)));
struct Unit { int pm, pn; };
struct Gemm { const bf16_t* A; const bf16_t* Bt; int lda, ldb, K; };
struct StaticOrder {
    int nM, nN, nwg, G, c;
    __host__ __device__ void init(int M, int N, int G_, int c_) { nM = M / BM; nN = N / BM; nwg = nM * nN; G = G_; c = c_; }
    __host__ __device__ bool next(int i, Unit& u) const {
        const long L = (long)i * G + c; if (L >= nwg) return false;
        int wgid = (int)L; { const int q = nwg / NXCD, r = nwg % NXCD, xcd = wgid % NXCD, off = wgid / NXCD; wgid = (xcd < r ? xcd * (q + 1) : r * (q + 1) + (xcd - r) * q) + off; }
        const int nig = WGM * nN, gid = wgid / nig, fm = gid * WGM, gsz = (nM - fm) < WGM ? (nM - fm) : WGM;
        u.pm = fm + ((wgid % nig) % gsz); u.pn = (wgid % nig) / gsz; return true;
    }
};
template <class Epi, class Sched, bool ALIGN_EPI, bool I8 = false>
__device__ __forceinline__ void gemm_phase(PG8_LAS unsigned char* lds, const Gemm g, const Sched& S, const Epi& E) {
    int tid = threadIdx.x; asm volatile("" : "+v"(tid));
    const int wid = __builtin_amdgcn_readfirstlane(tid >> 6), lane = tid & 63, wr = wid >> 2, wc = wid & 3, fr = lane & 15, fq = lane >> 4;
    const int K = g.K, nt = K / BK;
    unsigned voffA[2], voffB[2];
#pragma unroll
    for (int i = 0; i < 2; ++i) { int R, C; stage_rc(tid * 16 + i * 8192, R, C); const int Rb = (R & ~31) + perm32(R & 31);
        voffA[i] = (unsigned)(R * g.lda + C) * 2u; voffB[i] = (unsigned)(Rb * g.ldb + C) * 2u; }
    const size_t kstep = (size_t)(BK * 2);
    const size_t hstepA = (size_t)HALF * g.lda * 2, hstepB = (size_t)HALF * g.ldb * 2;
    const size_t tstepA = 2 * hstepA, tstepB = 2 * hstepB;
    const unsigned ldsw = (unsigned)wid * 1024u;
    const int aoff = lds_byte(wr * 64 + fr, fq * 8), boff = lds_byte(wc * 32 + fr, fq * 8);
#define PG8_SA(b, h) (((b) * 2 + (h)) * HTB)
#define PG8_SB(b, h) ((4 + (b) * 2 + (h)) * HTB)
#define PG8_STAGE(bufoff, gbase, voff) do { _Pragma("unroll") for (int _i = 0; _i < 2; ++_i) \
        __builtin_amdgcn_global_load_lds((const unsigned*)((const char*)(gbase) + (voff)[_i]), (PG8_LAS unsigned*)(lds + (bufoff) + ldsw + _i * 8192), 16, 0, 0); } while (0)
#define PG8_LDA(dst, b, h) do { _Pragma("unroll") for (int m = 0; m < 4; ++m) _Pragma("unroll") for (int k = 0; k < 2; ++k) dst[m][k] = *(const PG8_LAS bf16x8*)(lds + PG8_SA(b, h) + aoff + m * 2048 + k * 1024); } while (0)
#define PG8_LDB(dst, b, h) do { _Pragma("unroll") for (int n = 0; n < 2; ++n) _Pragma("unroll") for (int k = 0; k < 2; ++k) dst[n][k] = *(const PG8_LAS bf16x8*)(lds + PG8_SB(b, h) + boff + n * 2048 + k * 1024); } while (0)
#define PG8_MMA(ai, bj, At, Bt) do { __builtin_amdgcn_s_setprio(1); _Pragma("unroll") for (int m = 0; m < 4; ++m) _Pragma("unroll") for (int n = 0; n < 2; ++n) _Pragma("unroll") for (int k = 0; k < 2; ++k) { \
        if constexpr (I8) acc[ai][bj][m][n] = __builtin_bit_cast(f32x4, __builtin_amdgcn_mfma_i32_16x16x64_i8(__builtin_bit_cast(i32x4g, Bt[n][k]), __builtin_bit_cast(i32x4g, At[m][k]), __builtin_bit_cast(i32x4g, acc[ai][bj][m][n]), 0, 0, 0)); \
        else acc[ai][bj][m][n] = __builtin_amdgcn_mfma_f32_16x16x32_bf16(Bt[n][k], At[m][k], acc[ai][bj][m][n], 0, 0, 0); } __builtin_amdgcn_s_setprio(0); } while (0)
#define PG8_WAIT_V(n) asm volatile("s_waitcnt vmcnt(" #n ")" ::: "memory")
#define PG8_WAIT_L(n) asm volatile("s_waitcnt lgkmcnt(" #n ")" ::: "memory")
#define PG8_BAR __builtin_amdgcn_s_barrier()
#define PG8_SCHED __builtin_amdgcn_sched_barrier(0)
    Unit cur, nxt; int ui = 0;
    if (!S.next(0, cur)) return;
    f32x4 acc[2][2][4][2];
#pragma unroll
    for (int a = 0; a < 2; ++a)
#pragma unroll
        for (int b = 0; b < 2; ++b)
#pragma unroll
            for (int m = 0; m < 4; ++m)
#pragma unroll
                for (int n = 0; n < 2; ++n) acc[a][b][m][n] = (f32x4){0.f, 0.f, 0.f, 0.f};
    bf16x8 At[4][2], B0[2][2], B1[2][2];
    const char* cA = (const char*)g.A + (size_t)cur.pm * tstepA; const char* cB = (const char*)g.Bt + (size_t)cur.pn * tstepB;
    PG8_STAGE(PG8_SB(0, 0), cB, voffB); PG8_STAGE(PG8_SB(0, 1), cB + hstepB, voffB); PG8_STAGE(PG8_SA(0, 0), cA, voffA); PG8_STAGE(PG8_SA(0, 1), cA + hstepA, voffA);
    if (wr == 1) PG8_BAR;
    PG8_WAIT_V(2); PG8_BAR;
    PG8_STAGE(PG8_SB(1, 0), cB + kstep, voffB); PG8_STAGE(PG8_SA(1, 0), cA + kstep, voffA); PG8_STAGE(PG8_SB(1, 1), cB + hstepB + kstep, voffB);
    PG8_WAIT_V(6); PG8_BAR;
    for (;;) {
        const bool has_next = S.next(ui + 1, nxt);
        const char* nA = has_next ? (const char*)g.A + (size_t)nxt.pm * tstepA : cA; const char* nB = has_next ? (const char*)g.Bt + (size_t)nxt.pn * tstepB : cB;
        for (int t = 0; t < nt; t += 2) {
            const bool last = (t == nt - 2);
            const char* a1 = cA + (size_t)(t + 1) * kstep;
            const char* a2 = last ? nA : cA + (size_t)(t + 2) * kstep; const char* b2 = last ? nB : cB + (size_t)(t + 2) * kstep;
            const char* a3 = a2 + kstep; const char* b3 = b2 + kstep;
            PG8_LDB(B0, 0, 0); PG8_LDB(B1, 0, 1); PG8_SCHED; PG8_LDA(At, 0, 0); PG8_STAGE(PG8_SA(1, 1), a1 + hstepA, voffA);
            PG8_WAIT_V(8); PG8_WAIT_L(0); PG8_BAR; PG8_MMA(0, 0, At, B0); PG8_MMA(0, 1, At, B1); PG8_BAR; PG8_SCHED;
            PG8_LDA(At, 0, 1); PG8_STAGE(PG8_SB(0, 0), b2, voffB); PG8_STAGE(PG8_SB(0, 1), b2 + hstepB, voffB); PG8_STAGE(PG8_SA(0, 0), a2, voffA);
            PG8_WAIT_V(8); PG8_WAIT_L(0); PG8_BAR; PG8_MMA(1, 0, At, B0); PG8_MMA(1, 1, At, B1); PG8_BAR; PG8_SCHED;
            PG8_LDB(B0, 1, 0); PG8_LDB(B1, 1, 1); PG8_SCHED; PG8_LDA(At, 1, 0); PG8_STAGE(PG8_SA(0, 1), a2 + hstepA, voffA);
            PG8_WAIT_V(8); PG8_WAIT_L(0); PG8_BAR; PG8_MMA(0, 0, At, B0); PG8_MMA(0, 1, At, B1); PG8_BAR; PG8_SCHED;
            PG8_LDA(At, 1, 1); PG8_STAGE(PG8_SB(1, 0), b3, voffB); PG8_STAGE(PG8_SB(1, 1), b3 + hstepB, voffB); PG8_STAGE(PG8_SA(1, 0), a3, voffA);
            PG8_WAIT_V(8); PG8_WAIT_L(0); PG8_BAR; PG8_MMA(1, 0, At, B0); PG8_MMA(1, 1, At, B1); PG8_BAR; PG8_SCHED;
        }
        if constexpr (ALIGN_EPI) { if (wr == 0) PG8_BAR; }
        E(acc, cur, wr, wc, fr, fq);
        if (!has_next) break;
#pragma unroll
        for (int a = 0; a < 2; ++a)
#pragma unroll
            for (int b = 0; b < 2; ++b)
#pragma unroll
                for (int m = 0; m < 4; ++m)
#pragma unroll
                    for (int n = 0; n < 2; ++n) acc[a][b][m][n] = (f32x4){0.f, 0.f, 0.f, 0.f};
        cur = nxt; cA = nA; cB = nB; ++ui;
        if constexpr (ALIGN_EPI) { if (wr == 1) PG8_BAR; }
    }
    PG8_WAIT_V(0);
    if constexpr (!ALIGN_EPI) { if (wr == 0) PG8_BAR; }
    PG8_BAR;
#undef PG8_SA
#undef PG8_SB
#undef PG8_STAGE
#undef PG8_LDA
#undef PG8_LDB
#undef PG8_MMA
#undef PG8_WAIT_V
#undef PG8_WAIT_L
#undef PG8_BAR
#undef PG8_SCHED
}
}
typedef f32x4 Acc[2][2][4][2];
typedef int i32x4q __attribute__((ext_vector_type(4)));
__device__ __forceinline__ f32x4 deq4v(f32x4 accbits, f32x4 s, float sa) { const i32x4q i = __builtin_bit_cast(i32x4q, accbits); return (f32x4){(float)i[0], (float)i[1], (float)i[2], (float)i[3]} * s * sa; }
__device__ __forceinline__ f32x4 deq4(f32x4 accbits, const float* sw, float sa) { const i32x4q i = __builtin_bit_cast(i32x4q, accbits); const f32x4 s = *(const f32x4*)sw;
    return (f32x4){(float)i[0], (float)i[1], (float)i[2], (float)i[3]} * s * sa; }
__device__ __forceinline__ u32x4 pack8bf(f32x4 a, f32x4 b) { u32x4 w; w.x = pk2(a[0], a[1]); w.y = pk2(a[2], a[3]); w.z = pk2(b[0], b[1]); w.w = pk2(b[2], b[3]); return w; }
__device__ __forceinline__ void unpack8bf(u32x4 w, f32x4& a, f32x4& b) { a = (f32x4){bflo(w.x), bfhi(w.x), bflo(w.y), bfhi(w.y)}; b = (f32x4){bflo(w.z), bfhi(w.z), bflo(w.w), bfhi(w.w)}; }
__device__ __forceinline__ f32x4 sig4(f32x4 v) { return (f32x4){sigmoidf_(v[0]), sigmoidf_(v[1]), sigmoidf_(v[2]), sigmoidf_(v[3])}; }

#define EPI_ROW(s) (row0 + ((s) >> 2) * 128 + ((s) & 3) * 16)
struct Epi1 {
    bf16* Q; bf16* Kb; bf16* Vb; bf16* U; bf16* GA; bf16* GB; const float* SA; const float* SW; const float* qg; const float* kg; PG8_LAS float* X  ;
    __device__ __forceinline__ void operator()(const Acc& acc, const pg8::Unit& u, int wr, int wc, int fr, int fq) const {
        const int pn = u.pn, row0 = u.pm * 256 + wr * 64 + fr, cw = wc * 32 + 8 * fq;
        const int b = (u.pm * 256) >> 12, t0 = (row0 & 4095);
        f32x4 swv[2][2]; float sav[8];
#pragma unroll
        for (int bj = 0; bj < 2; ++bj) { swv[bj][0] = *(const f32x4*)(SW + pn * 256 + bj * 128 + cw); swv[bj][1] = *(const f32x4*)(SW + pn * 256 + bj * 128 + cw + 4); }
#pragma unroll
        for (int s = 0; s < 8; ++s) sav[s] = SA[EPI_ROW(s)];
        if (pn < 16) {
            const float* gg = pn < 8 ? qg : kg;
            const f32x4 g0 = *(const f32x4*)(gg + cw), g1 = *(const f32x4*)(gg + cw + 4);
            const int ln = fr + 16 * fq, ad16 = (ln ^ 16) << 2, ad32 = (ln ^ 32) << 2;
#pragma unroll
            for (int s = 0; s < 8; ++s) {
                const int ai = s >> 2, m = s & 3, rt = ai * 128 + wr * 64 + m * 16 + fr;
#pragma unroll
                for (int bj = 0; bj < 2; ++bj) {
                    const f32x4 v0 = deq4v(acc[ai][bj][m][0], swv[bj][0], sav[s]), v1 = deq4v(acc[ai][bj][m][1], swv[bj][1], sav[s]);
                    float ss = (v0[0] * v0[0] + v0[1] * v0[1]) + (v0[2] * v0[2] + v0[3] * v0[3]) + (v1[0] * v1[0] + v1[1] * v1[1]) + (v1[2] * v1[2] + v1[3] * v1[3]);
                    ss += __builtin_bit_cast(float, __builtin_amdgcn_ds_bpermute(ad16, __builtin_bit_cast(int, ss)));
                    ss += __builtin_bit_cast(float, __builtin_amdgcn_ds_bpermute(ad32, __builtin_bit_cast(int, ss)));
                    if (fq == 0) X[(rt * 2 + bj) * 4 + wc] = ss;
                }
            }
            asm volatile("s_waitcnt lgkmcnt(0)" ::: "memory"); __builtin_amdgcn_s_barrier();
            bf16* base = pn < 8 ? Q + ((size_t)((b * NH + pn * 2) * SEQ + t0)) * HD + cw : Kb + ((size_t)((b * NH + (pn - 8) * 2) * SKV + KVPAD + t0)) * HD + cw;
            const size_t hstride = pn < 8 ? (size_t)SEQ * HD : (size_t)SKV * HD;
#pragma unroll
            for (int s = 0; s < 8; ++s) {
                const int ai = s >> 2, m = s & 3, rt = ai * 128 + wr * 64 + m * 16 + fr;
#pragma unroll
                for (int bj = 0; bj < 2; ++bj) {
                    const f32x4 v0 = deq4v(acc[ai][bj][m][0], swv[bj][0], sav[s]), v1 = deq4v(acc[ai][bj][m][1], swv[bj][1], sav[s]);
                    const f32x4 pp = *(const PG8_LAS f32x4*)(X + (rt * 2 + bj) * 4);
                    const float rs = 1.0f / sqrtf(((pp[0] + pp[1]) + (pp[2] + pp[3])) * (1.f / HD) + EPS);
                    *(u32x4*)(base + (size_t)(ai * 128 + m * 16) * HD + bj * hstride) = pack8bf(v0 * rs * g0, v1 * rs * g1);
                }
            }
            return;
        }
        bf16* base; size_t rstride, bstride;
        if (pn < 24) { base = Vb + ((size_t)((b * NH + (pn - 16) * 2) * SKV + KVPAD + t0)) * HD + cw; rstride = HD; bstride = (size_t)SKV * HD; }
        else if (pn < 32) { base = U + (size_t)row0 * SSMW + (pn - 24) * 256 + cw; rstride = SSMW; bstride = 128; }
        else { base = (pn < 48 ? GA : GB) + (size_t)row0 * DM + (pn & 15) * 256 + cw; rstride = DM; bstride = 128; }
        if (pn < 32) {
#pragma unroll
            for (int s = 0; s < 8; ++s) { const int ai = s >> 2, m = s & 3;
#pragma unroll
                for (int bj = 0; bj < 2; ++bj)
                    *(u32x4*)(base + (size_t)(ai * 128 + m * 16) * rstride + bj * bstride) = pack8bf(deq4v(acc[ai][bj][m][0], swv[bj][0], sav[s]), deq4v(acc[ai][bj][m][1], swv[bj][1], sav[s])); }
        } else {
#pragma unroll
            for (int s = 0; s < 8; ++s) { const int ai = s >> 2, m = s & 3;
#pragma unroll
                for (int bj = 0; bj < 2; ++bj)
                    *(u32x4*)(base + (size_t)(ai * 128 + m * 16) * rstride + bj * bstride) = pack8bf(sig4(deq4v(acc[ai][bj][m][0], swv[bj][0], sav[s])), sig4(deq4v(acc[ai][bj][m][1], swv[bj][1], sav[s]))); }
        }
    }
};
struct EpiGlu {
    const bf16* Z; bf16* AS;
    __device__ __forceinline__ void operator()(const Acc& acc, const pg8::Unit& u, int wr, int wc, int fr, int fq) const {
        const int row0 = u.pm * 256 + wr * 64 + fr, col0 = u.pn * 256 + wc * 32 + 8 * fq;
        u32x4 zq[8][2];
#define EPI_LD(s) do { _Pragma("unroll") for (int bj = 0; bj < 2; ++bj) zq[s][bj] = *(const u32x4*)(Z + (size_t)EPI_ROW(s) * SSMW + col0 + bj * 128); } while (0)
        EPI_LD(0); EPI_LD(1);
#pragma unroll
        for (int s = 0; s < 8; ++s) { const int ai = s >> 2, m = s & 3;
            if (s + 2 < 8) EPI_LD((s + 2) & 7);
#pragma unroll
            for (int bj = 0; bj < 2; ++bj) { f32x4 z0, z1; unpack8bf(zq[s][bj], z0, z1);
                *(u32x4*)(AS + (size_t)EPI_ROW(s) * DM + SSMW + col0 + bj * 128) = pack8bf(z0 * sig4(acc[ai][bj][m][0]), z1 * sig4(acc[ai][bj][m][1])); } }
#undef EPI_LD
    }
};
struct EpiBrA {
    const bf16* GA; bf16* T; const float* SA; const float* SW;
    __device__ __forceinline__ void operator()(const Acc& acc, const pg8::Unit& u, int wr, int wc, int fr, int fq) const {
        const int row0 = u.pm * 256 + wr * 64 + fr, col0 = u.pn * 256 + wc * 32 + 8 * fq;
        f32x4 swv[2][2]; float sav[8]; u32x4 gq[8][2];
#pragma unroll
        for (int bj = 0; bj < 2; ++bj) { swv[bj][0] = *(const f32x4*)(SW + col0 + bj * 128); swv[bj][1] = *(const f32x4*)(SW + col0 + bj * 128 + 4); }
#pragma unroll
        for (int s = 0; s < 8; ++s) sav[s] = SA[EPI_ROW(s)];
#define EPI_LD(s) do { _Pragma("unroll") for (int bj = 0; bj < 2; ++bj) gq[s][bj] = *(const u32x4*)(GA + (size_t)EPI_ROW(s) * DM + col0 + bj * 128); } while (0)
        EPI_LD(0); EPI_LD(1);
#pragma unroll
        for (int s = 0; s < 8; ++s) { const int ai = s >> 2, m = s & 3;
            if (s + 2 < 8) EPI_LD((s + 2) & 7);
#pragma unroll
            for (int bj = 0; bj < 2; ++bj) { f32x4 g0, g1; unpack8bf(gq[s][bj], g0, g1);
                *(u32x4*)(T + (size_t)EPI_ROW(s) * DM + col0 + bj * 128) = pack8bf(g0 * deq4v(acc[ai][bj][m][0], swv[bj][0], sav[s]), g1 * deq4v(acc[ai][bj][m][1], swv[bj][1], sav[s])); } }
#undef EPI_LD
    }
};
struct EpiBrB {
    const bf16* GB; const bf16* T; bf16* MIX; const float* SA; const float* SW;
    __device__ __forceinline__ void operator()(const Acc& acc, const pg8::Unit& u, int wr, int wc, int fr, int fq) const {
        const int row0 = u.pm * 256 + wr * 64 + fr, col0 = u.pn * 256 + wc * 32 + 8 * fq;
        f32x4 swv[2][2]; float sav[8]; u32x4 gq[8][2], tq[8][2];
#pragma unroll
        for (int bj = 0; bj < 2; ++bj) { swv[bj][0] = *(const f32x4*)(SW + col0 + bj * 128); swv[bj][1] = *(const f32x4*)(SW + col0 + bj * 128 + 4); }
#pragma unroll
        for (int s = 0; s < 8; ++s) sav[s] = SA[EPI_ROW(s)];
#define EPI_LD(s) do { _Pragma("unroll") for (int bj = 0; bj < 2; ++bj) { const size_t o_ = (size_t)EPI_ROW(s) * DM + col0 + bj * 128; gq[s][bj] = *(const u32x4*)(GB + o_); tq[s][bj] = *(const u32x4*)(T + o_); } } while (0)
        EPI_LD(0);
#pragma unroll
        for (int s = 0; s < 8; ++s) { const int ai = s >> 2, m = s & 3;
            if (s + 1 < 8) EPI_LD((s + 1) & 7);
#pragma unroll
            for (int bj = 0; bj < 2; ++bj) { f32x4 g0, g1, t0, t1; unpack8bf(gq[s][bj], g0, g1); unpack8bf(tq[s][bj], t0, t1);
                *(u32x4*)(MIX + (size_t)EPI_ROW(s) * DM + col0 + bj * 128) = pack8bf(t0 + g0 * deq4v(acc[ai][bj][m][0], swv[bj][0], sav[s]), t1 + g1 * deq4v(acc[ai][bj][m][1], swv[bj][1], sav[s])); } }
#undef EPI_LD
    }
};
struct EpiOut {
    static constexpr int NS = 16;
    const float* X; const float* SA; const float* SW; bf16* H2B; float* PSS; PG8_LAS float* XL  ;
    __device__ __forceinline__ void operator()(const Acc& acc, const pg8::Unit& u, int wr, int wc, int fr, int fq) const {
        const int row0 = u.pm * 256 + wr * 64 + fr, col0 = u.pn * 256 + wc * 32 + 8 * fq;
        f32x4 swv[2][2]; float sav[8]; f32x4 xq[8][2][2];
#pragma unroll
        for (int bj = 0; bj < 2; ++bj) { swv[bj][0] = *(const f32x4*)(SW + col0 + bj * 128); swv[bj][1] = *(const f32x4*)(SW + col0 + bj * 128 + 4); }
#pragma unroll
        for (int s = 0; s < 8; ++s) sav[s] = SA[EPI_ROW(s)];
        const int ln = fr + 16 * fq, ad16 = (ln ^ 16) << 2, ad32 = (ln ^ 32) << 2;
#define EPI_LD(s) do { _Pragma("unroll") for (int bj = 0; bj < 2; ++bj) { const size_t o_ = (size_t)EPI_ROW(s) * DM + col0 + bj * 128; xq[s][bj][0] = *(const f32x4*)(X + o_); xq[s][bj][1] = *(const f32x4*)(X + o_ + 4); } } while (0)
        EPI_LD(0);
#pragma unroll
        for (int s = 0; s < 8; ++s) { const int ai = s >> 2, m = s & 3, rt = ai * 128 + wr * 64 + m * 16 + fr;
            if (s + 1 < 8) EPI_LD((s + 1) & 7);
            float ss = 0.f;
#pragma unroll
            for (int bj = 0; bj < 2; ++bj) { const size_t o = (size_t)EPI_ROW(s) * DM + col0 + bj * 128;
                const f32x4 h0 = xq[s][bj][0] + deq4v(acc[ai][bj][m][0], swv[bj][0], sav[s]), h1 = xq[s][bj][1] + deq4v(acc[ai][bj][m][1], swv[bj][1], sav[s]);
                *(u32x4*)(H2B + o) = pack8bf(h0, h1);
                ss += (h0[0] * h0[0] + h0[1] * h0[1]) + (h0[2] * h0[2] + h0[3] * h0[3]) + (h1[0] * h1[0] + h1[1] * h1[1]) + (h1[2] * h1[2] + h1[3] * h1[3]); }
            ss += __builtin_bit_cast(float, __builtin_amdgcn_ds_bpermute(ad16, __builtin_bit_cast(int, ss)));
            ss += __builtin_bit_cast(float, __builtin_amdgcn_ds_bpermute(ad32, __builtin_bit_cast(int, ss)));
            if (fq == 0) XL[rt * 4 + wc] = ss; }
#undef EPI_LD
        asm volatile("s_waitcnt lgkmcnt(0)" ::: "memory"); __builtin_amdgcn_s_barrier();
        const int tid = (wr * 4 + wc) * 64 + ln;
        if (tid < 256) { const f32x4 pp = *(const PG8_LAS f32x4*)(XL + tid * 4); PSS[(size_t)(u.pm * 256 + tid) * 16 + u.pn] = (pp[0] + pp[1]) + (pp[2] + pp[3]); }
    }
};
struct EpiQP {
    static constexpr int NS = 32;
    float* QP; const float* PSS;
    __device__ __forceinline__ void operator()(const Acc& acc, const pg8::Unit& u, int wr, int wc, int fr, int fq) const {
        const int row0 = u.pm * 256 + wr * 64 + fr, col0 = u.pn * 256 + wc * 32 + 8 * fq;
        float rs[8];
#pragma unroll
        for (int s = 0; s < 8; ++s) { const f32x4* p = (const f32x4*)(PSS + (size_t)EPI_ROW(s) * 16); const f32x4 a = (p[0] + p[1]) + (p[2] + p[3]);
            rs[s] = 1.0f / sqrtf(((a[0] + a[1]) + (a[2] + a[3])) * (1.f / DM) + EPS); }
#pragma unroll
        for (int s = 0; s < 8; ++s) { const int ai = s >> 2, m = s & 3;
#pragma unroll
            for (int bj = 0; bj < 2; ++bj) { float* d = QP + (size_t)EPI_ROW(s) * PEER_QW + col0 + bj * 128;
                *(f32x4*)d = acc[ai][bj][m][0] * rs[s]; *(f32x4*)(d + 4) = acc[ai][bj][m][1] * rs[s]; } }
    }
};
struct Ptrs {
    const float *x, *meta, *norm1_g, *w_in, *b_forget, *q_norm_g, *k_norm_g, *lam_re, *lam_im, *log_dt, *b_re, *b_im, *c_re, *c_im, *d_skip,
                *w_glu, *w_br_attn, *w_br_ssm, *w_out, *norm2_g, *w_query, *sub_keys, *expert_u, *expert_v;
    float* out; unsigned char* ws;
};

__device__ __forceinline__ void tr_tile(const float* W, int ldw, int col0, int ncols, int k0, bf16* WT, int ldk, int drow0, LAS float* scr, int lane) {
    const int c4 = 4 * (lane & 15), kq = lane >> 4;
    f32x4 vv[16];
#pragma unroll
    for (int i = 0; i < 16; ++i) { vv[i] = (f32x4){0.f, 0.f, 0.f, 0.f}; if (c4 < ncols) vv[i] = *(const f32x4*)(W + (size_t)(k0 + 4 * i + kq) * ldw + col0 + c4); }
#pragma unroll
    for (int i = 0; i < 16; ++i) { LAS float* s = scr + (4 * i + kq) * 65 + c4; s[0] = vv[i][0]; s[1] = vv[i][1]; s[2] = vv[i][2]; s[3] = vv[i][3]; }
    LDS_WAIT();
    const int c = lane & 7, nq = lane >> 3;
#pragma unroll 2
    for (int i = 0; i < 8; ++i) { const int n = 8 * i + nq; const LAS float* s = scr + (8 * c) * 65 + n;
        u32x4 o; o.x = pk2(s[0 * 65], s[1 * 65]); o.y = pk2(s[2 * 65], s[3 * 65]); o.z = pk2(s[4 * 65], s[5 * 65]); o.w = pk2(s[6 * 65], s[7 * 65]);
        if (n < ncols) *(u32x4*)(WT + (size_t)(drow0 + n) * ldk + k0 + 8 * c) = o; }
    LDS_WAIT();
}
__device__ __forceinline__ void absmax_tile(const float* W, int ldw, int k0, unsigned* cmax, int lane) {
    const float* wp = W + (size_t)k0 * ldw + 4 * lane; f32x4 m4 = (f32x4){0.f, 0.f, 0.f, 0.f};
#pragma unroll 8
    for (int k = 0; k < 64; ++k) { const f32x4 w = *(const f32x4*)(wp + (size_t)k * ldw); m4[0] = fmaxf(m4[0], fabsf(w[0])); m4[1] = fmaxf(m4[1], fabsf(w[1])); m4[2] = fmaxf(m4[2], fabsf(w[2])); m4[3] = fmaxf(m4[3], fabsf(w[3])); }
#pragma unroll
    for (int e = 0; e < 4; ++e) atomicMax(cmax + 4 * lane + e, __builtin_bit_cast(unsigned, m4[e]));
}
__device__ __forceinline__ void tr_tile_q8(const float* W, int ldw, int c0, int k0, unsigned char* W8, int ld8, int kofs, int n0, const unsigned* cmax, float* SW, LAS float* scr, int lane) {
    const int c4 = 4 * (lane & 15), kq = lane >> 4;
    const int c = lane & 7, nq = lane >> 3;
    f32x4 vv[16]; float cmv[8];
#pragma unroll
    for (int i = 0; i < 16; ++i) vv[i] = *(const f32x4*)(W + (size_t)(k0 + 4 * i + kq) * ldw + c0 + c4);
#pragma unroll
    for (int i = 0; i < 8; ++i) cmv[i] = __builtin_bit_cast(float, cmax[n0 + 8 * i + nq]);
#pragma unroll
    for (int i = 0; i < 16; ++i) { LAS float* s = scr + (4 * i + kq) * 65 + c4; s[0] = vv[i][0]; s[1] = vv[i][1]; s[2] = vv[i][2]; s[3] = vv[i][3]; }
    LDS_WAIT();
#pragma unroll 2
    for (int i = 0; i < 8; ++i) { const int n = 8 * i + nq; const LAS float* s = scr + (8 * c) * 65 + n;
        const float cm = cmv[i], inv = cm > 0.f ? 127.0f / cm : 0.f;
        unsigned q0 = 0u, q1 = 0u;
#pragma unroll
        for (int e = 0; e < 4; ++e) { q0 |= ((unsigned)(int)fminf(fmaxf(rintf(s[e * 65] * inv), -127.f), 127.f) & 0xffu) << (8 * e); q1 |= ((unsigned)(int)fminf(fmaxf(rintf(s[(4 + e) * 65] * inv), -127.f), 127.f) & 0xffu) << (8 * e); }
        *(u32x2*)(W8 + (size_t)(n0 + n) * ld8 + kofs + k0 + 8 * c) = (u32x2){q0, q1};
        if (k0 == 0 && c == 0) SW[n0 + n] = cm > 0.f ? cm * (1.0f / 127.0f) : 1.0f; }
    LDS_WAIT();
}
__device__ __forceinline__ void rowq8_load(u32x4 (&raw)[8], const bf16* src, int lane) {
#pragma unroll
    for (int j = 0; j < 8; ++j) raw[j] = *((const u32x4*)src + 64 * j + lane);
}
template <bool TWO> __device__ __forceinline__ void rowq8(const u32x4 (&raw)[8], unsigned char* dst, float* sc, int lane) {
    f32x4 a[8], b[8]; float m0 = 0.f, m1 = 0.f;
#pragma unroll
    for (int j = 0; j < 8; ++j) { unpack8bf(raw[j], a[j], b[j]);
        const float m = fmaxf(fmaxf(fmaxf(fabsf(a[j][0]), fabsf(a[j][1])), fmaxf(fabsf(a[j][2]), fabsf(a[j][3]))), fmaxf(fmaxf(fabsf(b[j][0]), fabsf(b[j][1])), fmaxf(fabsf(b[j][2]), fabsf(b[j][3]))));
        if (j < 4) m0 = fmaxf(m0, m); else m1 = fmaxf(m1, m); }
#pragma unroll
    for (int o = 1; o < 64; o <<= 1) { m0 = fmaxf(m0, __shfl_xor(m0, o)); m1 = fmaxf(m1, __shfl_xor(m1, o)); }
    if (!TWO) { m0 = fmaxf(m0, m1); m1 = m0; }
    const float s0 = m0 > 0.f ? m0 * (1.0f / 127.0f) : 1.0f, s1 = m1 > 0.f ? m1 * (1.0f / 127.0f) : 1.0f, i0 = 1.0f / s0, i1 = 1.0f / s1;
#pragma unroll
    for (int j = 0; j < 8; ++j) { const float inv = j < 4 ? i0 : i1; unsigned q0 = 0u, q1 = 0u;
#pragma unroll
        for (int e = 0; e < 4; ++e) { q0 |= ((unsigned)(int)fminf(fmaxf(rintf(a[j][e] * inv), -127.f), 127.f) & 0xffu) << (8 * e); q1 |= ((unsigned)(int)fminf(fmaxf(rintf(b[j][e] * inv), -127.f), 127.f) & 0xffu) << (8 * e); }
        *((u32x2*)dst + 64 * j + lane) = (u32x2){q0, q1}; }
    if (lane == 0) { sc[0] = s0; if (TWO) sc[NTOK] = s1; }
}
__device__ __forceinline__ void tr_tile_i8(const float* W, int n0, int k0, unsigned char* W8, const unsigned* cmax, float* SW, LAS float* scr, int lane) {
    const int c4 = 4 * (lane & 15), kq = lane >> 4;
    const int c = lane & 7, nq = lane >> 3;
    f32x4 vv[16]; float cmv[8];
#pragma unroll
    for (int i = 0; i < 16; ++i) vv[i] = *(const f32x4*)(W + (size_t)(k0 + 4 * i + kq) * NCOLS_SRC + n0 + (n0 >= 6144 ? 16 : 0) + c4);
#pragma unroll
    for (int i = 0; i < 8; ++i) cmv[i] = __builtin_bit_cast(float, cmax[n0 + 8 * i + nq]);
#pragma unroll
    for (int i = 0; i < 16; ++i) { LAS float* s = scr + (4 * i + kq) * 65 + c4; s[0] = vv[i][0]; s[1] = vv[i][1]; s[2] = vv[i][2]; s[3] = vv[i][3]; }
    LDS_WAIT();
#pragma unroll 2
    for (int i = 0; i < 8; ++i) { const int n = 8 * i + nq; const LAS float* s = scr + (8 * c) * 65 + n;
        const float cm = cmv[i], inv = cm > 0.f ? 127.0f / cm : 0.f;
        unsigned q0 = 0u, q1 = 0u;
#pragma unroll
        for (int e = 0; e < 4; ++e) { q0 |= ((unsigned)(int)fminf(fmaxf(rintf(s[e * 65] * inv), -127.f), 127.f) & 0xffu) << (8 * e); q1 |= ((unsigned)(int)fminf(fmaxf(rintf(s[(4 + e) * 65] * inv), -127.f), 127.f) & 0xffu) << (8 * e); }
        *(u32x2*)(W8 + (size_t)(n0 + n) * DM + k0 + 8 * c) = (u32x2){q0, q1};
        if (k0 == 0 && c == 0) SW[n0 + n] = cm > 0.f ? cm * (1.0f / 127.0f) : 1.0f; }
    LDS_WAIT();
}
__device__ __forceinline__ void split8(f32x4 x0, f32x4 x1, bf16x8& hi, bf16x8& lo) {
    const u32x4 h = pack8bf(x0, x1); f32x4 h0, h1; unpack8bf(h, h0, h1);
    hi = __builtin_bit_cast(bf16x8, h); lo = __builtin_bit_cast(bf16x8, pack8bf(x0 - h0, x1 - h1));
}
__device__ __forceinline__ void wq_fold_task(const Ptrs& P, int task, int lane) {
    const int hc = task >> 8, j0 = (task & 255) * 16, c = hc & 1, r = lane & 15, q = lane >> 4;
    bf16x8 ah[4], al[4];
    const float* wrow = P.w_query + (size_t)(j0 + r) * PEER_QW + hc * 128 + 8 * q; const float gj = P.norm2_g[j0 + r];
#pragma unroll
    for (int kb = 0; kb < 4; ++kb) split8(*(const f32x4*)(wrow + 32 * kb) * gj, *(const f32x4*)(wrow + 32 * kb + 4) * gj, ah[kb], al[kb]);
    bf16* out = (bf16*)(P.ws + WS_WQ) + (size_t)(hc * 128 + r) * DM + j0 + 4 * q;
    u32x2 ov[8];
#pragma unroll
    for (int nt = 0; nt < 8; ++nt) {
        const float* krow = P.sub_keys + (size_t)(c * 128 + nt * 16 + r) * 128 + 8 * q;
        f32x4 acc = (f32x4){0.f, 0.f, 0.f, 0.f};
#pragma unroll
        for (int kb = 0; kb < 4; ++kb) { bf16x8 bh, bl; split8(*(const f32x4*)(krow + 32 * kb), *(const f32x4*)(krow + 32 * kb + 4), bh, bl);
            acc = __builtin_amdgcn_mfma_f32_16x16x32_bf16(al[kb], bh, acc, 0, 0, 0); acc = __builtin_amdgcn_mfma_f32_16x16x32_bf16(ah[kb], bl, acc, 0, 0, 0);
            acc = __builtin_amdgcn_mfma_f32_16x16x32_bf16(ah[kb], bh, acc, 0, 0, 0); }
        ov[nt] = (u32x2){pk2(acc[0], acc[1]), pk2(acc[2], acc[3])};
    }
#pragma unroll
    for (int nt = 0; nt < 8; ++nt) *(u32x2*)(out + (size_t)(nt * 16) * DM) = ov[nt];
}
__device__ __forceinline__ void p0_prologue(const Ptrs& P, LAS unsigned char* lds, int gw, int NGW, int wave, int lane) {
    LAS float* scr = (LAS float*)(lds + wave * 16640);
    unsigned char* ws = P.ws;
    bf16* WT1 = (bf16*)(ws + WS_WT1); bf16* WGLU = (bf16*)(ws + WS_WGLU); bf16* WAB = (bf16*)(ws + WS_WAB); bf16* WOUT = (bf16*)(ws + WS_WOUT);
    constexpr int I0 = 64 * 64, I1 = 64, I2 = 64 * 32, I3 = 32 * 32;
    constexpr int NITEMS = I0 + I1 + I2 + I3;
    for (int it = gw; it < NITEMS; it += NGW) {
        int r = it;
        if (r < I0) { tr_tile(P.w_in, NCOLS_SRC, 2048 + (r % 64) * 64, 64, (r / 64) * 64, WT1, DM, C_K + (r % 64) * 64, scr, lane); continue; } r -= I0;
        if (r < I1) { tr_tile(P.w_in, NCOLS_SRC, 6144, 16, r * 64, WT1, DM, C_F, scr, lane); continue; } r -= I1;
        if (r < I2) { tr_tile(P.w_in, NCOLS_SRC, 6160 + (r % 32) * 64, 64, (r / 32) * 64, WT1, DM, C_U + (r % 32) * 64, scr, lane); continue; } r -= I2;
        tr_tile(P.w_glu, SSMW, (r % 32) * 64, 64, (r / 32) * 64, WGLU, SSMW, (r % 32) * 64, scr, lane);
    }
    for (int task = gw; task < 16 * 256; task += NGW) wq_fold_task(P, task, lane);
}
__device__ __forceinline__ void rms_row_load(f32x4 (&v)[16], const float* xrow, int lane) {
    const f32x4* xr = (const f32x4*)xrow + lane;
#pragma unroll
    for (int j = 0; j < 16; ++j) v[j] = xr[64 * j];
}
__device__ __forceinline__ void rms_row_proc(f32x4 (&v)[16], const f32x4 (&gv)[16], bf16* orow, int lane, unsigned char* orow8 = nullptr, float* sa_out = nullptr) {
    float s = 0.f;
#pragma unroll
    for (int j = 0; j < 16; ++j) s += (v[j][0] * v[j][0] + v[j][1] * v[j][1]) + (v[j][2] * v[j][2] + v[j][3] * v[j][3]);
    const float rs = 1.0f / sqrtf(wave_sum(s) * (1.f / DM) + EPS);
    u32x2* o8 = (u32x2*)orow + lane;
    float am = 0.f;
#pragma unroll
    for (int j = 0; j < 16; ++j) { const f32x4 gg = gv[j]; v[j] = v[j] * rs * gg; u32x2 w; w.x = pk2(v[j][0], v[j][1]); w.y = pk2(v[j][2], v[j][3]); o8[64 * j] = w;
        am = fmaxf(am, fmaxf(fmaxf(fabsf(v[j][0]), fabsf(v[j][1])), fmaxf(fabsf(v[j][2]), fabsf(v[j][3])))); }
    if (orow8) {
#pragma unroll
        for (int o = 1; o < 64; o <<= 1) am = fmaxf(am, __shfl_xor(am, o));
        const float sa = am > 0.f ? am * (1.0f / 127.0f) : 1.0f, inv = 1.0f / sa;
#pragma unroll
        for (int j = 0; j < 16; ++j) { unsigned q = 0u;
#pragma unroll
            for (int e = 0; e < 4; ++e) q |= ((unsigned)(int)fminf(fmaxf(rintf(v[j][e] * inv), -127.f), 127.f) & 0xffu) << (8 * e);
            ((unsigned*)orow8)[lane + 64 * j] = q; }
        if (lane == 0) *sa_out = sa;
    }
}

__device__ __forceinline__ f32x4 skinny_tile(const bf16* A, const bf16* Bt, int lane) {
    const bf16* ap = A + (size_t)(lane & 15) * DM + 8 * (lane >> 4); const bf16* bp = Bt + (size_t)(lane & 15) * DM + 8 * (lane >> 4);
    f32x4 acc = (f32x4){0.f, 0.f, 0.f, 0.f};
    for (int k0 = 0; k0 < DM; k0 += 256) {
        bf16x8 a[8], b[8];
#pragma unroll
        for (int i = 0; i < 8; ++i) { a[i] = *(const bf16x8*)(ap + k0 + 32 * i); b[i] = *(const bf16x8*)(bp + k0 + 32 * i); }
#pragma unroll
        for (int i = 0; i < 8; ++i) acc = __builtin_amdgcn_mfma_f32_16x16x32_bf16(a[i], b[i], acc, 0, 0, 0);
    }
    return acc;
}
__device__ __forceinline__ float log_sigmoid_(float x) { const float e = __expf(-fabsf(x)); return fminf(x, 0.f) - __logf(1.f + e); }
__device__ __forceinline__ void p1_prelude(const Ptrs& P, int gw, int NGW, int lane) {
    unsigned char* ws = P.ws;
    const bf16* HN = (const bf16*)(ws + WS_HN); const bf16* WT1 = (const bf16*)(ws + WS_WT1);
    float* LOGF = (float*)(ws + WS_LOGF); bf16* Kb = (bf16*)(ws + WS_K); bf16* Vb = (bf16*)(ws + WS_V); bf16* UM = (bf16*)(ws + WS_UMETA);
    constexpr int NF = NROWS / 16  , NMT = (3 * 2048) / 16  ;
    for (int it = gw; it < NF + NMT; it += NGW) {
        if (it < NF) {
            const f32x4 acc = skinny_tile(HN + (size_t)it * 16 * DM, WT1 + (size_t)C_F * DM, lane);
            const int h = lane & 15; const float bf = P.b_forget[h];
#pragma unroll
            for (int j = 0; j < 4; ++j) LOGF[(size_t)(it * 16 + 4 * (lane >> 4) + j) * 16 + h] = log_sigmoid_(acc[j] + bf);
        } else {
            const int ct = it - NF, cc = C_K + 16 * ct + (lane & 15);
            const f32x4 acc = skinny_tile(HN + (size_t)NTOK * DM, WT1 + (size_t)(C_K + 16 * ct) * DM, lane);
#pragma unroll
            for (int j = 0; j < 4; ++j) { const int mr = 4 * (lane >> 4) + j;
                if (cc < C_U) { bf16* dst = (cc < C_V) ? Kb : Vb; const int c2 = (cc < C_V) ? cc - C_K : cc - C_V, h = c2 >> 7, d = c2 & 127; const bf16 v = (bf16)f2bf(acc[j]);
#pragma unroll
                    for (int b = 0; b < NB; ++b) dst[((size_t)((b * NH + h) * SKV + (KVPAD - NMETA) + mr)) * HD + d] = v; }
                else UM[mr * SSMW + (cc - C_U)] = (bf16)f2bf(acc[j]); }
        }
    }
}

__device__ __forceinline__ void p2_cumsum(const Ptrs& P, int bh, int lane) {
    const float* LOGF = (const float*)(P.ws + WS_LOGF); float* BIAS = (float*)(P.ws + WS_BIAS) + (size_t)bh * SKV;
    const int b = bh >> 4, h = bh & 15, j0 = 65 * lane;
    float lf[65]; float tot = 0.f;
#pragma unroll
    for (int i = 0; i < 65; ++i) { const int pos = j0 + i - (KVPAD - NMETA);
        lf[i] = (pos < 0) ? 0.f : (pos < NMETA ? LOGF[(size_t)(NTOK + pos) * 16 + h] : LOGF[(size_t)(b * SEQ + pos - NMETA) * 16 + h]); }
#pragma unroll
    for (int i = 0; i < 65; ++i) tot += lf[i];
    float incl = tot;
#pragma unroll
    for (int o = 1; o < 64; o <<= 1) { const float n = __shfl_up(incl, o); if (lane >= o) incl += n; }
    float run = incl - tot;
#pragma unroll
    for (int i = 0; i < 65; ++i) { const int jp = j0 + i, pos = jp - (KVPAD - NMETA); run += lf[i];
        BIAS[jp] = (pos < 0) ? -__builtin_inff() : -run * 11.313708498984761f; }
}
__device__ __forceinline__ void qknorm4(bf16* rows  , const float* g, int lane) {
    bf16* p = rows + (size_t)(lane >> 4) * HD + 8 * (lane & 15);
    f32x4 a, b; unpack8bf(*(const u32x4*)p, a, b);
    float ss = (a[0] * a[0] + a[1] * a[1]) + (a[2] * a[2] + a[3] * a[3]) + (b[0] * b[0] + b[1] * b[1]) + (b[2] * b[2] + b[3] * b[3]);
    ss += __shfl_xor(ss, 1); ss += __shfl_xor(ss, 2); ss += __shfl_xor(ss, 4); ss += __shfl_xor(ss, 8);
    const float rs = 1.0f / sqrtf(ss * (1.f / HD) + EPS);
    const f32x4 g0 = *(const f32x4*)(g + 8 * (lane & 15)), g1 = *(const f32x4*)(g + 8 * (lane & 15) + 4);
    *(u32x4*)p = pack8bf(a * rs * g0, b * rs * g1);
}
__device__ __forceinline__ void p2_qknorm_zero(const Ptrs& P, int gw, int NGW, int lane) {
    bf16* Q = (bf16*)(P.ws + WS_Q); bf16* Kb = (bf16*)(P.ws + WS_K); bf16* Vb = (bf16*)(P.ws + WS_V);
    for (int it = gw; it < 64 * (NMETA / 4); it += NGW) { const int bh = it / (NMETA / 4), gq = it % (NMETA / 4); qknorm4(Kb + ((size_t)bh * SKV + (KVPAD - NMETA) + 4 * gq) * HD, P.k_norm_g, lane); }
    for (int it = gw; it < 128; it += NGW) { bf16* base = ((it & 1) ? Vb : Kb) + (size_t)(it >> 1) * SKV * HD;
        for (int i = lane; i < (KVPAD - NMETA) * HD * 2 / 16; i += 64) ((u32x4*)base)[i] = (u32x4){0u, 0u, 0u, 0u}; }
}

__device__ __forceinline__ void sincos_(float x, float& s, float& c) {
    const float k = rintf(x * 0.6366197723675814f); const int q = (int)k;
    float r = fmaf(k, -1.5703125f, x); r = fmaf(k, -4.837512969970703125e-4f, r); r = fmaf(k, -7.54978995489188e-8f, r);
    const float z = r * r;
    const float sp = r + r * z * (-1.6666654611e-1f + z * (8.3321608736e-3f + z * (-1.9515295891e-4f)));
    const float cp = 1.0f - 0.5f * z + z * z * (4.166664568298827e-2f + z * (-1.388731625493765e-3f + z * 2.443315711809948e-5f));
    const int qq = q & 3;
    s = (qq == 0) ? sp : (qq == 1) ? cp : (qq == 2) ? -sp : -cp;
    c = (qq == 0) ? cp : (qq == 1) ? -sp : (qq == 2) ? -cp : sp;
}
__device__ __forceinline__ void s5_tables(const Ptrs& P, int g, int lane) {
    unsigned char* T = P.ws + WS_S5T; const int p = lane;
    const float dt = expf(P.log_dt[g]), lr = P.lam_re[g * NS + p], li = P.lam_im[g * NS + p];
    const float mag = expf(lr * dt); float sn, cs; sincos_(li * dt, sn, cs);
    const float ar = mag * cs, ai = mag * sn, nr = ar - 1.0f, den = lr * lr + li * li;
    const float fr = (nr * lr + ai * li) / den, fi = (ai * lr - nr * li) / den;
    *((f32x2*)(T + S5T_AT) + g * NS + p) = (f32x2){ar, ai};
    float bbr[GC], bbi[GC];
    { const f32x4* brp = (const f32x4*)(P.b_re + (size_t)(g * NS + p) * GC); const f32x4* bip = (const f32x4*)(P.b_im + (size_t)(g * NS + p) * GC);
#pragma unroll
      for (int q = 0; q < 4; ++q) { const f32x4 br = brp[q], bi = bip[q];
#pragma unroll
          for (int e = 0; e < 4; ++e) { bbr[4 * q + e] = fr * br[e] - fi * bi[e]; bbi[4 * q + e] = fr * bi[e] + fi * br[e]; } } }
    { u32x4* bf = (u32x4*)(T + S5T_BFR) + (size_t)(g * 8 + (p >> 3)) * 64; const int m0 = 2 * (p & 7);
      bf[m0]      = (u32x4){pk2(bbr[0], bbr[1]), pk2(bbr[2], bbr[3]), pk2(bbr[4], bbr[5]), pk2(bbr[6], bbr[7])};
      bf[m0 + 16] = (u32x4){pk2(bbr[8], bbr[9]), pk2(bbr[10], bbr[11]), pk2(bbr[12], bbr[13]), pk2(bbr[14], bbr[15])};
      bf[m0 + 1]  = (u32x4){pk2(bbi[0], bbi[1]), pk2(bbi[2], bbi[3]), pk2(bbi[4], bbi[5]), pk2(bbi[6], bbi[7])};
      bf[m0 + 17] = (u32x4){pk2(bbi[8], bbi[9]), pk2(bbi[10], bbi[11]), pk2(bbi[12], bbi[13]), pk2(bbi[14], bbi[15])};
      const u32x4 z = (u32x4){0u, 0u, 0u, 0u}; bf[m0 + 32] = z; bf[m0 + 33] = z; bf[m0 + 48] = z; bf[m0 + 49] = z; }
    { const int c = lane & 15, kq = lane >> 4;
#pragma unroll
      for (int ks = 0; ks < 4; ++ks) { const int p0 = 16 * ks + 4 * kq;
          const f32x4 cr = *(const f32x4*)(P.c_re + (size_t)(g * GC + c) * NS + p0), ci = *(const f32x4*)(P.c_im + (size_t)(g * GC + c) * NS + p0);
          *((u32x4*)(T + S5T_CFR) + (size_t)(g * 4 + ks) * 64 + lane) = (u32x4){pk2(cr[0], -ci[0]), pk2(cr[1], -ci[1]), pk2(cr[2], -ci[2]), pk2(cr[3], -ci[3])}; } }
}
template <bool FINAL>
__device__ __forceinline__ void s5_unit(const Ptrs& P, int b, int g, int ch, LAS float* xl, LAS unsigned* sl, int lane) {
    const bf16* U = (const bf16*)(P.ws + WS_U); const bf16* UM = (const bf16*)(P.ws + WS_UMETA); float* E = (float*)(P.ws + WS_S5E); bf16* Z = (bf16*)(P.ws + WS_Z);
    const unsigned char* T = P.ws + WS_S5T; const int p = lane, t16 = lane & 15, q4 = lane >> 4;
    const f32x2 aa = *((const f32x2*)(T + S5T_AT) + g * NS + p); const float ar = aa[0], ai = aa[1];
    bf16x8 bfr[8];
#pragma unroll
    for (int mb = 0; mb < 8; ++mb) bfr[mb] = *((const bf16x8*)(T + S5T_BFR) + (size_t)(g * 8 + mb) * 64 + lane);
    bf16x8 cfr[4]; float dsk = 0.f;
    if (FINAL) {
#pragma unroll
        for (int ks = 0; ks < 4; ++ks) cfr[ks] = *((const bf16x8*)(T + S5T_CFR) + (size_t)(g * 4 + ks) * 64 + lane);
        dsk = P.d_skip[g * GC + t16];
    }
    float sr = 0.f, si = 0.f;
#define S5_LDU(dst, UP, urow0) do { dst = (bf16x8){0, 0, 0, 0, 0, 0, 0, 0}; if (q4 < 2) dst = *(const bf16x8*)((UP) + (size_t)((urow0) + t16) * SSMW + g * GC + 8 * q4); } while (0)
#define S5_LDS(dst, UP, urow0) do { _Pragma("unroll") for (int j = 0; j < 4; ++j) dst[j] = (UP)[(size_t)((urow0) + 4 * q4 + j) * SSMW + g * GC + t16]; } while (0)
#define S5_BLOCK(ub_, us_, urow0, OUT) do { \
        _Pragma("unroll") for (int mb = 0; mb < 8; ++mb) { const f32x4 d_ = __builtin_amdgcn_mfma_f32_16x16x32_bf16(bfr[mb], ub_, (f32x4){0.f, 0.f, 0.f, 0.f}, 0, 0, 0); \
            *(LAS f32x4*)(xl + t16 * 132 + 16 * mb + 4 * q4) = d_; } \
        LDS_WAIT(); \
        f32x2 xv_[16]; unsigned pv_[16];        \
        _Pragma("unroll") for (int tt = 0; tt < 16; ++tt) xv_[tt] = *(const LAS f32x2*)(xl + tt * 132 + 2 * p); \
        _Pragma("unroll") for (int tt = 0; tt < 16; ++tt) { \
            const float nsr = fmaf(ar, sr, fmaf(-ai, si, xv_[tt][0])), nsi = fmaf(ar, si, fmaf(ai, sr, xv_[tt][1])); sr = nsr; si = nsi; \
            if (OUT) pv_[tt] = pk2(sr, si); } \
        if (OUT) { _Pragma("unroll") for (int tt = 0; tt < 16; ++tt) sl[tt * 68 + p] = pv_[tt]; \
            LDS_WAIT(); \
            f32x4 y_ = (f32x4){0.f, 0.f, 0.f, 0.f}; \
            _Pragma("unroll") for (int ks = 0; ks < 4; ++ks) { const bf16x8 af_ = *(const LAS bf16x8*)(sl + t16 * 68 + 16 * ks + 4 * q4); y_ = __builtin_amdgcn_mfma_f32_16x16x32_bf16(af_, cfr[ks], y_, 0, 0, 0); } \
            _Pragma("unroll") for (int j = 0; j < 4; ++j) { const size_t row_ = (size_t)((urow0) + 4 * q4 + j); const float u_ = __builtin_bit_cast(float, (unsigned)us_[j] << 16); \
                Z[row_ * SSMW + g * GC + t16] = (bf16)f2bf(gelu_tanh(fmaf(dsk, u_, y_[j]))); } } \
        LDS_WAIT(); } while (0)
    bf16x8 ubc, ubn; bf16 usc[4] = {0, 0, 0, 0}, usn[4] = {0, 0, 0, 0};
    if (ch == 0) { S5_LDU(ubc, UM, 0); S5_BLOCK(ubc, usc, 0, false); }
    else if (FINAL) {
        float pr = ar, pi = ai;
#pragma unroll
        for (int q = 0; q < 9; ++q) { const float t = pr * pr - pi * pi; pi = 2.0f * pr * pi; pr = t; }
        f32x2 ev[NCH - 1];
#pragma unroll
        for (int c = 0; c < NCH - 1; ++c) { ev[c] = (f32x2){0.f, 0.f}; if (c < ch) ev[c] = *(const f32x2*)(E + ((size_t)((b * NG + g) * NCH + c) * NS + p) * 2); }
#pragma unroll
        for (int c = 0; c < NCH - 1; ++c) if (c < ch) { const float t = pr * sr - pi * si + ev[c][0]; si = pr * si + pi * sr + ev[c][1]; sr = t; }
    }
    const int row00 = b * SEQ + ch * LCH;
    S5_LDU(ubn, U, row00); if (FINAL) S5_LDS(usn, U, row00);
    for (int blk = 0; blk < LCH / 16; ++blk) {
        ubc = ubn;
#pragma unroll
        for (int j = 0; j < 4; ++j) usc[j] = usn[j];
        const int nrow = row00 + (blk + 1 < LCH / 16 ? blk + 1 : blk) * 16;
        S5_LDU(ubn, U, nrow); if (FINAL) S5_LDS(usn, U, nrow);
        S5_BLOCK(ubc, usc, row00 + blk * 16, FINAL); }
    if (!FINAL) *(f32x2*)(E + ((size_t)((b * NG + g) * NCH + ch) * NS + p) * 2) = (f32x2){sr, si};
#undef S5_BLOCK
#undef S5_LDU
#undef S5_LDS
}
namespace att {
using bf16 = __hip_bfloat16;
constexpr int D = 128, OSTR = 4096;
constexpr bool WSKIP = false; constexpr float THR = 8.f;
constexpr float SCALE = 0.08838834764831845f;
constexpr int NW = 8, QBLK = 32, KVBLK = 64, QB = NW * QBLK;
constexpr int SHM_V = KVBLK * D * 2, SHM_K = KVBLK * D * 2;
constexpr int LDS_BIAS = 2 * SHM_V + 2 * SHM_K + NW * 64 * 4;
constexpr int LDS_BYTES = LDS_BIAS + 2 * 64 * 4;

template <class A, class Bt> struct same_t { static constexpr bool v = false; };
template <class A> struct same_t<A, A> { static constexpr bool v = true; };

#define KSWZ(row, colB) ((row) * 256 + ((colB) ^ (((row) & 7) << 4)))
#define SBAR() __builtin_amdgcn_sched_barrier(0)
__device__ __forceinline__ int v_st(int k, int c) { const int kk = (k & ~0xC) | ((k & 4) << 1) | ((k & 8) >> 1); return ((kk >> 3) * 4 + (c >> 5)) * 512 + ((kk & 7) * 32 + (c & 31)) * 2; }
__device__ __forceinline__ int v_rd_base(int lane) { return ((lane & 3) << 3) | (((lane >> 2) & 3) << 6) | (((lane >> 4) & 1) << 5) | (((lane >> 5) & 1) << 8); }
constexpr int v_rd_off(int d0, int ks, int half) { return d0 * 512 + ks * 4096 + half * 2048; }
__device__ __forceinline__ int crow(int r, int hi) { return (r & 3) + 8 * (r >> 2) + 4 * hi; }
__device__ __forceinline__ unsigned cvtpk(float lo, float hi) {
    return pk2(lo, hi);
}
__device__ __forceinline__ bf16x8 pack8(f32x4 a, f32x4 b) {
    u32x4 w = {cvtpk(a[0], a[1]), cvtpk(a[2], a[3]), cvtpk(b[0], b[1]), cvtpk(b[2], b[3])};
    return *reinterpret_cast<bf16x8*>(&w);
}
template <class T> __device__ __forceinline__ bf16x8 load8(const T* p) {
    if constexpr (same_t<T, float>::v) { return pack8(*(const f32x4*)p, *(const f32x4*)(p + 4)); }
    else { return *reinterpret_cast<const bf16x8*>(p); }
}
__device__ __forceinline__ void mask_tile(f32x16& p0, f32x16& p1, int dq, unsigned W) {
    const float NEG = -__builtin_inff();
#pragma unroll
    for (int r = 0; r < 16; ++r) {
        const int c = (r & 3) + 8 * (r >> 2);
        if ((unsigned)(dq - c) >= W) p0[r] = NEG;
        if ((unsigned)(dq - c - 32) >= W) p1[r] = NEG;
    }
}
__device__ __forceinline__ void partialSM(f32x16& p0, f32x16& p1, float& m_reg, float& mn, float& alpha) {
    float pmax = p0[0]; for (int r = 1; r < 16; ++r) pmax = fmaxf(pmax, p0[r]); for (int r = 0; r < 16; ++r) pmax = fmaxf(pmax, p1[r]);
    { auto rr = __builtin_amdgcn_permlane32_swap(__float_as_uint(pmax), __float_as_uint(pmax), false, false);
      pmax = fmaxf(__uint_as_float(rr[0]), __uint_as_float(rr[1])); }
    constexpr float C2 = 1.4426950408889634f * SCALE;
    if (__builtin_expect(__all((pmax - m_reg) * SCALE <= THR), 1)) { mn = m_reg; alpha = 1.f; }
    else { mn = fmaxf(m_reg, pmax); alpha = __builtin_amdgcn_exp2f((m_reg - mn) * C2); m_reg = mn; }
    const float mnL = -mn * C2;
    for (int r = 0; r < 16; ++r) p0[r] = fmaf(p0[r], C2, mnL); for (int r = 0; r < 16; ++r) p1[r] = fmaf(p1[r], C2, mnL);
    for (int r = 0; r < 16; ++r) p0[r] = __builtin_amdgcn_exp2f(p0[r]);
}
__device__ __forceinline__ void finishSM(f32x16& p0, f32x16& p1, float alpha, float& l_reg, bf16x8& pa0, bf16x8& pa1, bf16x8& pa2, bf16x8& pa3) {
    for (int r = 0; r < 16; ++r) p1[r] = __builtin_amdgcn_exp2f(p1[r]);
    float ps = 0; for (int r = 0; r < 16; ++r) ps += p0[r]; for (int r = 0; r < 16; ++r) ps += p1[r];
    { auto rr = __builtin_amdgcn_permlane32_swap(__float_as_uint(ps), __float_as_uint(ps), false, false);
      ps = __uint_as_float(rr[0]) + __uint_as_float(rr[1]); }
    l_reg = l_reg * alpha + ps;
#define PK4(P, B_, OUT) do { unsigned a0 = cvtpk(P[B_+0], P[B_+1]), a1 = cvtpk(P[B_+2], P[B_+3]);                          \
        unsigned b0 = cvtpk(P[B_+4], P[B_+5]), b1 = cvtpk(P[B_+6], P[B_+7]);                                             \
        auto r0 = __builtin_amdgcn_permlane32_swap(a0, b0, false, false); auto r1 = __builtin_amdgcn_permlane32_swap(a1, b1, false, false); \
        u32x4 w = {r0[0], r1[0], r0[1], r1[1]}; OUT = *reinterpret_cast<bf16x8*>(&w); } while (0)
    PK4(p0, 0, pa0); PK4(p0, 8, pa1); PK4(p1, 0, pa2); PK4(p1, 8, pa3);
#undef PK4
}
template <int KB, bool SK>
__device__ __forceinline__ void qkt(f32x16& p0, f32x16& p1, const char* K_lds, int r32, int hi, const bf16x8* qr, bool act) {
    if (SK && !act) { const float NEG = -__builtin_inff();
#pragma unroll
        for (int r = 0; r < 16; ++r) { p0[r] = NEG; p1[r] = NEG; } return; }
    { const float* bl = (const float*)(K_lds + 2 * SHM_K + NW * 64 * 4) + KB * 64 + 4 * hi;
      const f32x4 b0 = *(const f32x4*)(bl), b1 = *(const f32x4*)(bl + 8), b2 = *(const f32x4*)(bl + 16), b3 = *(const f32x4*)(bl + 24);
      const f32x4 c0 = *(const f32x4*)(bl + 32), c1 = *(const f32x4*)(bl + 40), c2 = *(const f32x4*)(bl + 48), c3 = *(const f32x4*)(bl + 56);
      p0 = (f32x16){b0[0], b0[1], b0[2], b0[3], b1[0], b1[1], b1[2], b1[3], b2[0], b2[1], b2[2], b2[3], b3[0], b3[1], b3[2], b3[3]};
      p1 = (f32x16){c0[0], c0[1], c0[2], c0[3], c1[0], c1[1], c1[2], c1[3], c2[0], c2[1], c2[2], c2[3], c3[0], c3[1], c3[2], c3[3]}; }
    const char* kb[4];
#pragma unroll
    for (int dd = 0; dd < 4; ++dd) kb[dd] = K_lds + KB * SHM_K + KSWZ(r32, (dd * 16 + hi * 8) * 2);
#pragma unroll
    for (int d0 = 0; d0 < 8; ++d0) { const char* a = kb[d0 & 3] + (d0 >> 2) * 128;
        bf16x8 b0 = *reinterpret_cast<const bf16x8*>(a);
        bf16x8 b1 = *reinterpret_cast<const bf16x8*>(a + 32 * 256);
        p0 = __builtin_amdgcn_mfma_f32_32x32x16_bf16(b0, qr[d0], p0, 0, 0, 0);
        p1 = __builtin_amdgcn_mfma_f32_32x32x16_bf16(b1, qr[d0], p1, 0, 0, 0); }
}
template <int VB, bool SK>
__device__ __forceinline__ void pv_tile(f32x16* o, int vb0, bf16x8 pa0, bf16x8 pa1, bf16x8 pa2, bf16x8 pa3, bool act) {
    if (SK && !act) return;
#define TRRD(dst, off) asm volatile("ds_read_b64_tr_b16 %0, %1 offset:%2" : "=&v"(dst) : "v"(vb0), "i"(off) : "memory")
#define PV_D0(d0) do { s16x4 l0, l1, l2, l3, h0, h1, h2, h3; constexpr int b_ = VB * SHM_V + v_rd_off(d0, 0, 0);     \
        TRRD(l0, b_); TRRD(h0, b_ + 2048); TRRD(l1, b_ + 4096); TRRD(h1, b_ + 6144); TRRD(l2, b_ + 8192); TRRD(h2, b_ + 10240); TRRD(l3, b_ + 12288); TRRD(h3, b_ + 14336); \
        asm volatile("s_waitcnt lgkmcnt(0)" ::: "memory"); SBAR();                 \
        o[d0] = __builtin_amdgcn_mfma_f32_32x32x16_bf16(pa0, (bf16x8){l0[0], l0[1], l0[2], l0[3], h0[0], h0[1], h0[2], h0[3]}, o[d0], 0, 0, 0);   \
        o[d0] = __builtin_amdgcn_mfma_f32_32x32x16_bf16(pa1, (bf16x8){l1[0], l1[1], l1[2], l1[3], h1[0], h1[1], h1[2], h1[3]}, o[d0], 0, 0, 0);   \
        o[d0] = __builtin_amdgcn_mfma_f32_32x32x16_bf16(pa2, (bf16x8){l2[0], l2[1], l2[2], l2[3], h2[0], h2[1], h2[2], h2[3]}, o[d0], 0, 0, 0);   \
        o[d0] = __builtin_amdgcn_mfma_f32_32x32x16_bf16(pa3, (bf16x8){l3[0], l3[1], l3[2], l3[3], h3[0], h3[1], h3[2], h3[3]}, o[d0], 0, 0, 0); } while (0)
    PV_D0(0); PV_D0(1); PV_D0(2); PV_D0(3);
#undef PV_D0
#undef TRRD
}

template <class TIn, class TOut> struct BlockRef { const TIn* Q; const TIn* K; const TIn* V; TOut* O; const float* Bias; int P0; };
template <class TIn> struct Seam {
    bf16x8 qr[8];
    bf16x8 st_v0, st_v1, st_k0, st_k1; f32x4 sf0, sf1, sf2, sf3; float st_b;
    f32x4 tq[16];
};
__device__ __forceinline__ int swa_jlo(int P0, int W) { const int lowk = P0 - W + 1; return lowk > 0 ? lowk / KVBLK : 0; }
#define ROW(p, k0, rr) ((p) + (size_t)((k0) + (rr)) * D + sc)
#define VMW() asm volatile("s_waitcnt vmcnt(0)" ::: "memory")
#define VMWN(n) asm volatile("s_waitcnt vmcnt(%0)" :: "i"(n) : "memory")
#define SLOAD_H(Kp, Vp, k0) do { S.st_v0 = load8<TIn>(ROW(Vp, k0, sr)); S.st_v1 = load8<TIn>(ROW(Vp, k0, 32 + sr));              \
                         S.st_k0 = load8<TIn>(ROW(Kp, k0, sr)); S.st_k1 = load8<TIn>(ROW(Kp, k0, 32 + sr)); if (wid == 0) S.st_b = BiasP[(k0) + lane]; } while (0)
#define SWRITE_HK(bf) do { *(bf16x8*)(K_lds + (bf) * SHM_K + kws) = S.st_k0; *(bf16x8*)(K_lds + (bf) * SHM_K + kws + 32 * 256) = S.st_k1; \
                           if (wid == 0) ((float*)(K_lds + 2 * SHM_K + NW * 64 * 4))[(bf) * 64 + lane] = S.st_b; } while (0)
#define SWRITE_HV(bf) do { *(bf16x8*)(V_lds + (bf) * SHM_V + vst0) = S.st_v0; *(bf16x8*)(V_lds + (bf) * SHM_V + vst1) = S.st_v1; } while (0)
#define SWRITE_H(bf) do { SWRITE_HV(bf); SWRITE_HK(bf); } while (0)
#define SLOAD_F(p, k0) do { S.sf0 = *(const f32x4*)ROW(p, k0, sr); S.sf1 = *(const f32x4*)(ROW(p, k0, sr) + 4);                \
                            S.sf2 = *(const f32x4*)ROW(p, k0, 32 + sr); S.sf3 = *(const f32x4*)(ROW(p, k0, 32 + sr) + 4); } while (0)
#define SWRITE_KF(bf) do { *(bf16x8*)(K_lds + (bf) * SHM_K + kws) = pack8(S.sf0, S.sf1); *(bf16x8*)(K_lds + (bf) * SHM_K + kws + 32 * 256) = pack8(S.sf2, S.sf3); } while (0)
#define SWRITE_VF(bf) do { *(bf16x8*)(V_lds + (bf) * SHM_V + vst0) = pack8(S.sf0, S.sf1); *(bf16x8*)(V_lds + (bf) * SHM_V + vst1) = pack8(S.sf2, S.sf3); } while (0)
template <class TIn, class TOut>
__device__ __forceinline__ void causal_swa_prime(const BlockRef<TIn, TOut>& cur, int W, char* lds, Seam<TIn>& S) {
    constexpr bool F32 = same_t<TIn, float>::v;
    int tid_ = threadIdx.x; asm volatile("" : "+v"(tid_)); const int tid = tid_, wid = __builtin_amdgcn_readfirstlane(tid >> 6), lane = tid & 63, r32 = lane & 31, hi = lane >> 5;
    const int sr = tid >> 4, sc = (tid & 15) * 8, kws = KSWZ(sr, sc * 2); char* K_lds = lds + 2 * SHM_V;
    const int kb0 = swa_jlo(cur.P0, W) * KVBLK; const float* BiasP = cur.Bias;
    for (int d0 = 0; d0 < 8; ++d0) S.qr[d0] = load8<TIn>(cur.Q + (size_t)(wid * QBLK + r32) * D + d0 * 16 + hi * 8);
    if constexpr (F32) { SLOAD_F((const float*)cur.K, kb0); VMW(); SWRITE_KF(0); SBAR(); SLOAD_F((const float*)cur.V, kb0); }
    else { SLOAD_H(cur.K, cur.V, kb0); VMW(); SWRITE_HK(0); }
    __syncthreads();
}
template <class TIn, class TOut>
__device__ __forceinline__ void causal_swa_block(const BlockRef<TIn, TOut>& cur, const BlockRef<TIn, TOut>& nxt, int skv, int W, char* lds, Seam<TIn>& S) {
    constexpr bool F32 = same_t<TIn, float>::v;
    int tid_ = threadIdx.x; asm volatile("" : "+v"(tid_)); const int tid = tid_, wid = __builtin_amdgcn_readfirstlane(tid >> 6), lane = tid & 63, r32 = lane & 31, hi = lane >> 5;
    const int j_lo = swa_jlo(cur.P0, W);
    int j_hi = (cur.P0 + QB - 1) / KVBLK + 1; if (j_hi > skv / KVBLK) j_hi = skv / KVBLK;
    const int NT = j_hi - j_lo;
    const int kbn = swa_jlo(nxt.P0, W) * KVBLK;
    const int qlo = cur.P0 + wid * QBLK, qm = qlo + r32 - 4 * hi;
    char* V_lds = lds; char* K_lds = lds + 2 * SHM_V;
    float* ws = (float*)(lds + 2 * SHM_V + 2 * SHM_K) + wid * 64; float* li_l = ws, * al_l = ws + 32;
    float m_reg = -1e30f, l_reg = 0; f32x16 o[4] = {};
    const int sr = tid >> 4, sc = (tid & 15) * 8, vst0 = v_st(sr, sc), vst1 = v_st(32 + sr, sc), kws = KSWZ(sr, sc * 2);
    const int vb0 = (int)(uintptr_t)V_lds + v_rd_base(lane);
    const TIn* Kh = cur.K; const TIn* Vh = cur.V; const float* BiasP = cur.Bias;
#define RESC(a) do { if (__any((a) < 1.f)) { if (hi == 0) al_l[r32] = (a); asm volatile("s_waitcnt lgkmcnt(0)" ::: "memory");              \
                     for (int d_ = 0; d_ < 4; ++d_) for (int r = 0; r < 16; ++r) o[d_][r] *= al_l[crow(r, hi)]; } } while (0)
#define KBASE(t) ((j_lo + (t)) * KVBLK)
#define ACT(t) (KBASE(t) <= qlo + QBLK - 1 && KBASE(t) + KVBLK - 1 >= qlo - W + 1)
#define MASKT(P0_, P1_, t) do { const int kb_ = KBASE(t); if ((!SK || ACT(t)) && (kb_ + KVBLK - 1 > qlo || kb_ <= qlo + QBLK - 1 - W)) mask_tile(P0_, P1_, qm - kb_, (unsigned)W); } while (0)
    constexpr int NQL = F32 ? 16 : 8;
    constexpr bool SK = WSKIP && !F32;
#define SEAM_K0() do { VMWN(NQL); if constexpr (F32) { SWRITE_KF(0); SBAR(); SLOAD_F((const float*)nxt.V, kbn); } else { SWRITE_HK(0); } SBAR(); } while (0)
    f32x16 pA0, pA1, pB0, pB1; float mnA, mnB, alA, alB; bf16x8 pa0, pa1, pa2, pa3;
    if constexpr (F32) { VMW(); SWRITE_VF(0); SBAR(); } else { SWRITE_HV(0); SBAR(); }
    if (NT > 1) { if constexpr (F32) SLOAD_F((const float*)Kh, KBASE(1)); else SLOAD_H(Kh, Vh, KBASE(1)); }
    SBAR(); qkt<0, SK>(pA0, pA1, K_lds, r32, hi, S.qr, ACT(0));
    if constexpr (F32) { if (NT > 1) { VMW(); SWRITE_KF(1); SBAR(); SLOAD_F((const float*)Vh, KBASE(1)); } }
    MASKT(pA0, pA1, 0); partialSM(pA0, pA1, m_reg, mnA, alA);
    if (NT > 1) { VMW(); if constexpr (F32) { SWRITE_VF(1); SBAR(); if (NT > 2) SLOAD_F((const float*)Kh, KBASE(2)); } else SWRITE_H(1); }
    __syncthreads();
#define HALF_STEP(PX0, PX1, mnX, alX, PY0, PY1, alY, t, KB, VB, SB) do {                                                      \
        SBAR(); qkt<KB, SK>(PX0, PX1, K_lds, r32, hi, S.qr, ACT(t));                                             \
        finishSM(PY0, PY1, alY, l_reg, pa0, pa1, pa2, pa3); SBAR();                                                           \
        if ((t) + 1 < NT) { if constexpr (F32) { VMW(); SWRITE_KF(SB); SBAR(); SLOAD_F((const float*)Vh, KBASE((t) + 1)); }  \
                            else { SLOAD_H(Kh, Vh, KBASE((t) + 1)); } SBAR(); }                                               \
        pv_tile<VB, SK>(o, vb0, pa0, pa1, pa2, pa3, ACT((t) - 1)); MASKT(PX0, PX1, (t)); partialSM(PX0, PX1, m_reg, mnX, alX);                                        \
        __syncthreads();                                                                                                      \
        if ((t) + 1 < NT) { VMW(); if constexpr (F32) { SWRITE_VF(SB); SBAR(); if ((t) + 2 < NT) SLOAD_F((const float*)Kh, KBASE((t) + 2)); } \
                            else { SWRITE_H(SB); } }                                                                          \
        RESC(alX); __syncthreads(); } while (0)
    for (int t = 1; t + 1 < NT; t += 2) {
        HALF_STEP(pB0, pB1, mnB, alB, pA0, pA1, alA, t, 1, 0, 0);
        HALF_STEP(pA0, pA1, mnA, alA, pB0, pB1, alB, t + 1, 0, 1, 1);
    }
    const bool even = (NT & 1) == 0;
    if (even) { SBAR(); qkt<1, SK>(pB0, pB1, K_lds, r32, hi, S.qr, ACT(NT - 1)); SBAR(); }
#define QROW(e) (nxt.Q + (size_t)(wid * QBLK + r32) * D + ((e) >> 1) * 16 + hi * 8 + ((e) & 1) * 4)
    if constexpr (F32) { SLOAD_F((const float*)nxt.K, kbn); SBAR();
#pragma unroll
        for (int e = 0; e < 8; ++e) S.tq[e] = *(const f32x4*)QROW(e); }
    else { { const float* BiasP = nxt.Bias; SLOAD_H(nxt.K, nxt.V, kbn); } SBAR();
#pragma unroll
        for (int d0 = 0; d0 < 8; ++d0) S.qr[d0] = load8<TIn>(nxt.Q + (size_t)(wid * QBLK + r32) * D + d0 * 16 + hi * 8); }
    SBAR();
    finishSM(pA0, pA1, alA, l_reg, pa0, pa1, pa2, pa3); SBAR();
    if constexpr (F32) {
#pragma unroll
        for (int e = 8; e < 16; ++e) S.tq[e] = *(const f32x4*)QROW(e); SBAR(); }
#undef QROW
    pv_tile<0, SK>(o, vb0, pa0, pa1, pa2, pa3, ACT(even ? NT - 2 : NT - 1));
    if (even) { MASKT(pB0, pB1, NT - 1); partialSM(pB0, pB1, m_reg, mnB, alB); __syncthreads(); RESC(alB);
        finishSM(pB0, pB1, alB, l_reg, pa0, pa1, pa2, pa3); SBAR(); pv_tile<1, SK>(o, vb0, pa0, pa1, pa2, pa3, ACT(NT - 1)); }
    SBAR(); SEAM_K0();
    if (hi == 0) li_l[r32] = l_reg; asm volatile("s_waitcnt lgkmcnt(0)" ::: "memory");
    float rli[16];
#pragma unroll
    for (int r = 0; r < 16; ++r) rli[r] = __builtin_amdgcn_rcpf(li_l[crow(r, hi)]);
    TOut* Ow = cur.O + (size_t)(wid * QBLK) * OSTR;
#pragma unroll
    for (int r = 0; r < 16; ++r) { const int orow = crow(r, hi);
#pragma unroll
        for (int d0 = 0; d0 < 4; ++d0) { const float v = o[d0][r] * rli[r];
            if constexpr (same_t<TOut, float>::v) { Ow[(size_t)orow * OSTR + d0 * 32 + r32] = v; }
            else { const float vn = __builtin_bit_cast(float, __builtin_amdgcn_update_dpp(0, __builtin_bit_cast(int, v), 0xB1  , 0xf, 0xf, true));
                   if ((r32 & 1) == 0) *(unsigned*)(Ow + (size_t)orow * OSTR + d0 * 32 + r32) = cvtpk(v, vn); } } }
    if constexpr (F32) {
#pragma unroll
        for (int d0 = 0; d0 < 8; ++d0) S.qr[d0] = pack8(S.tq[2 * d0], S.tq[2 * d0 + 1]); }
    __syncthreads();
#undef RESC
#undef KBASE
#undef ACT
#undef MASKT
#undef SEAM_K0
#undef HALF_STEP
}
#undef ROW
#undef VMW
#undef VMWN
#undef SLOAD_H
#undef SWRITE_HK
#undef SWRITE_HV
#undef SWRITE_H
#undef SLOAD_F
#undef SWRITE_KF
#undef SWRITE_VF
}
__device__ __forceinline__ att::BlockRef<att::bf16, att::bf16> attn_ref(const Ptrs& P, int bh, int qb) {
    att::BlockRef<att::bf16, att::bf16> r; const int b = bh >> 4, h = bh & 15;
    r.Q = (const att::bf16*)(P.ws + WS_Q) + ((size_t)bh * SEQ + (size_t)qb * 256) * HD;
    r.K = (const att::bf16*)(P.ws + WS_K) + (size_t)bh * SKV * HD; r.V = (const att::bf16*)(P.ws + WS_V) + (size_t)bh * SKV * HD;
    r.O = (att::bf16*)(P.ws + WS_AS) + ((size_t)b * SEQ + (size_t)qb * 256) * DM + h * HD;
    r.Bias = (const float*)(P.ws + WS_BIAS) + (size_t)bh * SKV; r.P0 = KVPAD + qb * 256;
    return r;
}
__device__ __forceinline__ void attn_phase(const Ptrs& P, char* lds, int vcu, int G) {
    constexpr int NX = 8, TOTAL = NX * NB * NH, WBIG = 1 << 20;
    int L = vcu; if (L >= TOTAL) return;
    int pass = 0;
    att::BlockRef<att::bf16, att::bf16> cur = attn_ref(P, L >> 3, L & 7);
    att::Seam<att::bf16> S;
    att::causal_swa_prime<att::bf16, att::bf16>(cur, WBIG, lds, S);
    for (;;) {
        const bool more_pass = pass == 0, more_item = L + G < TOTAL, last = !more_pass && !more_item;
        int passn = pass + 1, Ln = L;
        if (!more_pass) { passn = 0; Ln = more_item ? L + G : L; }
        const int qbn = passn ? 15 - (Ln & 7) : (Ln & 7);
        const att::BlockRef<att::bf16, att::bf16> nxt = last ? cur : attn_ref(P, Ln >> 3, qbn);
        att::causal_swa_block<att::bf16, att::bf16>(cur, nxt, SKV, WBIG, lds, S);
        if (last) break;
        cur = nxt; pass = passn; L = Ln;
    }
}

__device__ __forceinline__ float dpp_xor1(float v) { return __builtin_bit_cast(float, __builtin_amdgcn_update_dpp(0, __builtin_bit_cast(int, v), 0xB1, 0xf, 0xf, true)); }
__device__ __forceinline__ float dpp_xor2(float v) { return __builtin_bit_cast(float, __builtin_amdgcn_update_dpp(0, __builtin_bit_cast(int, v), 0x4E, 0xf, 0xf, true)); }
__device__ __forceinline__ unsigned fkey(float f) { const unsigned u = __builtin_bit_cast(unsigned, f); return u ^ ((u >> 31) ? 0xFFFFFFFFu : 0x80000000u); }
template <int NV> __device__ __forceinline__ unsigned thr16(const unsigned (&k)[NV]) {
    unsigned prefix = 0u;
    for (int bit = 31; bit >= 0; --bit) {
        const unsigned cand = prefix | (1u << bit); int cnt = 0;
#pragma unroll
        for (int v = 0; v < NV; ++v) cnt += __popcll(__ballot(k[v] >= cand));
        if (cnt >= 16) prefix = cand;
        if (cnt == 16) break;
    }
    return prefix;
}
__device__ __forceinline__ float dot2bf(unsigned a, unsigned b, float acc) { asm volatile("v_dot2c_f32_bf16 %0, %1, %2" : "+v"(acc) : "v"(a), "v"(b)); return acc; }
__device__ __forceinline__ float dot8(u32x4 w, u32x4 x, float acc) {
    acc = dot2bf(w.x, x.x, acc); acc = dot2bf(w.y, x.y, acc); acc = dot2bf(w.z, x.z, acc); acc = dot2bf(w.w, x.w, acc);
    return acc;
}
__device__ __forceinline__ void peer_select(const Ptrs& P, int tok, LAS float* TV, LAS int* TI, LAS int* EX, LAS float* GT, int lane) {
    const float* QP = (const float*)(P.ws + WS_GA) + (size_t)tok * PEER_QW;
    const unsigned long long lt = (1ull << lane) - 1ull;
    for (int c = 0; c < 2; ++c) {
        float s0[PEER_H], s1[PEER_H];
#pragma unroll
        for (int h = 0; h < PEER_H; ++h) { s0[h] = QP[h * 256 + c * 128 + lane]; s1[h] = QP[h * 256 + c * 128 + 64 + lane]; }
#pragma unroll
        for (int h = 0; h < PEER_H; ++h) {
            const unsigned kk[2] = {fkey(s0[h]), fkey(s1[h])}; const unsigned T = thr16<2>(kk);
            const unsigned long long m0 = __ballot(kk[0] >= T), m1 = __ballot(kk[1] >= T);
            const int r0 = __popcll(m0 & lt), r1 = __popcll(m0) + __popcll(m1 & lt), row = h * 2 + c;
            if (kk[0] >= T && r0 < 16) { TV[row * 16 + r0] = s0[h]; TI[row * 16 + r0] = lane; }
            if (kk[1] >= T && r1 < 16) { TV[row * 16 + r1] = s1[h]; TI[row * 16 + r1] = lane + 64; }
        }
    }
    LDS_WAIT();
    for (int h = 0; h < PEER_H; ++h) {
        const int i = lane >> 2, jb = 4 * (lane & 3);
        const float a = TV[(h * 2) * 16 + i]; const f32x4 b4 = *(const LAS f32x4*)(TV + (h * 2 + 1) * 16 + jb);
        const float cd[4] = {a + b4[0], a + b4[1], a + b4[2], a + b4[3]};
        const unsigned kk[4] = {fkey(cd[0]), fkey(cd[1]), fkey(cd[2]), fkey(cd[3])}; const unsigned T = thr16<4>(kk);
        const int i1 = TI[(h * 2) * 16 + i]; int base = 0;
#pragma unroll
        for (int v = 0; v < 4; ++v) { const unsigned long long m = __ballot(kk[v] >= T); const int r = base + __popcll(m & lt); base += __popcll(m);
            if (kk[v] >= T && r < 16) { GT[h * 16 + r] = cd[v]; EX[h * 16 + r] = i1 * PEER_K + TI[(h * 2 + 1) * 16 + jb + v]; } }
    }
    LDS_WAIT();
#pragma unroll
    for (int ps = 0; ps < 2; ++ps) { const int idx = ps * 64 + lane; const float v = GT[idx];
        float mx = v; mx = fmaxf(mx, dpp_xor1(mx)); mx = fmaxf(mx, dpp_xor2(mx)); mx = fmaxf(mx, __shfl_xor(mx, 4)); mx = fmaxf(mx, __shfl_xor(mx, 8));
        const float e = __expf(v - mx); float sm = e; sm += dpp_xor1(sm); sm += dpp_xor2(sm); sm += __shfl_xor(sm, 4); sm += __shfl_xor(sm, 8);
        LDS_WAIT(); GT[idx] = e / sm; }
    LDS_WAIT();
}
__device__ __forceinline__ void peer_gather(const Ptrs& P, int tok, const LAS int* EX, const LAS float* GT, const LAS int* EXN, bool first, u32x4 (&R)[8][2], unsigned (&SCW)[8], int lane) {
    const bf16* HN2 = (const bf16*)(P.ws + WS_HN) + (size_t)tok * DM; const unsigned char* E4 = P.ws + WS_E4;
    float rs_tok; { const f32x4* p = (const f32x4*)((const float*)(P.ws + WS_PSS) + (size_t)tok * 16); const f32x4 a = (p[0] + p[1]) + (p[2] + p[3]); rs_tok = 1.0f / sqrtf(((a[0] + a[1]) + (a[2] + a[3])) * (1.f / DM) + EPS); }
    float* orow = P.out + (size_t)tok * DM;
    int xq[2][4], xr[2][4]; float sx[2];
    u32x4 xa[2][4];
#pragma unroll
    for (int c = 0; c < 2; ++c)
#pragma unroll
        for (int q = 0; q < 4; ++q) xa[c][q] = *((const u32x4*)HN2 + 256 * c + 4 * lane + q);
#pragma unroll
    for (int c = 0; c < 2; ++c) { float xf[32];
#pragma unroll
        for (int q = 0; q < 4; ++q) { const u32x4 a = xa[c][q];
            xf[8 * q + 0] = bflo(a.x); xf[8 * q + 1] = bfhi(a.x); xf[8 * q + 2] = bflo(a.y); xf[8 * q + 3] = bfhi(a.y); xf[8 * q + 4] = bflo(a.z); xf[8 * q + 5] = bfhi(a.z); xf[8 * q + 6] = bflo(a.w); xf[8 * q + 7] = bfhi(a.w); }
        float am = 0.f;
#pragma unroll
        for (int i = 0; i < 32; ++i) am = fmaxf(am, fabsf(xf[i]));
        const float s_ = am > 0.f ? am * (1.0f / 7.0f) : 1.0f, inv = 1.0f / s_; sx[c] = s_ * rs_tok;
#pragma unroll
        for (int d = 0; d < 4; ++d) { unsigned wq = 0u, wr = 0u;
#pragma unroll
            for (int n = 0; n < 8; ++n) { const float t_ = xf[8 * d + n] * inv, q1 = fminf(fmaxf(rintf(t_), -7.f), 7.f); const int qv = (int)q1, rv = (int)fminf(fmaxf(rintf((t_ - q1) * 14.0f), -7.f), 7.f);
                wq |= ((unsigned)qv & 15u) << (4 * n); wr |= ((unsigned)rv & 15u) << (4 * n); }
            xq[c][d] = (int)wq; xr[c][d] = (int)wr; }
        asm volatile("" : "+v"(xq[c][0]), "+v"(xq[c][1]), "+v"(xq[c][2]), "+v"(xq[c][3]), "+v"(xr[c][0]), "+v"(xr[c][1]), "+v"(xr[c][2]), "+v"(xr[c][3]), "+v"(sx[c])); __builtin_amdgcn_sched_barrier(0); }
    float yoff[2] = {0.f, 0.f};
    f32x2 y[2][16];
#pragma unroll
    for (int c = 0; c < 2; ++c)
#pragma unroll
        for (int e = 0; e < 16; ++e) y[c][e] = (f32x2){0.f, 0.f};
    const int klane = 8 * ((lane >> 5) & 1) + 4 * ((lane >> 4) & 1) + 2 * ((lane >> 3) & 1) + ((lane >> 2) & 1);
    const unsigned lane16u = (unsigned)lane * 16u, lane4u = (unsigned)(lane >> 1) * 4u;
#define PEER_ISSUE(slot, tab, e_) do { const unsigned ri_ = (unsigned)(tab) * PEER_N + (unsigned)(e_);        \
        const GAS unsigned char* rb_ = (const GAS unsigned char*)E4 + (size_t)ri_ * E4ROW;        \
        R[slot][0] = *(const GAS u32x4*)(rb_ + lane16u); R[slot][1] = *(const GAS u32x4*)(rb_ + lane16u + 1024u); SCW[slot] = *(const GAS unsigned*)(rb_ + 2048u + lane4u); } while (0)
    int ex[16], exn[7];
#pragma unroll
    for (int k = 0; k < 16; ++k) ex[k] = __builtin_amdgcn_readfirstlane(EX[k]);
    if (first) { PEER_ISSUE(0, 0, ex[0]); PEER_ISSUE(1, 0, ex[1]); PEER_ISSUE(2, 0, ex[2]); PEER_ISSUE(3, 0, ex[3]); PEER_ISSUE(4, 0, ex[4]); PEER_ISSUE(5, 0, ex[5]); PEER_ISSUE(6, 0, ex[6]); }
    for (int h = 0; h < PEER_H; ++h) {
        const int hn = (h + 1 < PEER_H) ? h + 1 : h;
#pragma unroll
        for (int k = 0; k < 7; ++k) exn[k] = __builtin_amdgcn_readfirstlane((h + 1 < PEER_H) ? EX[hn * 16 + k] : EXN[k]);
        float part[16]; float w = 0.f;
#define PEER_PIN8(c, o) asm volatile("" : "+v"(y[c][o + 0]), "+v"(y[c][o + 1]), "+v"(y[c][o + 2]), "+v"(y[c][o + 3]), "+v"(y[c][o + 4]), "+v"(y[c][o + 5]), "+v"(y[c][o + 6]), "+v"(y[c][o + 7]))
#define PEER_PIN_Y() do { PEER_PIN8(0, 0); PEER_PIN8(0, 8); PEER_PIN8(1, 0); PEER_PIN8(1, 8); } while (0)
#define PEER_RED16() do { float p8[8], p4[4], p2[2], p1; \
            { const bool hb = (lane & 32) != 0; _Pragma("unroll") for (int i = 0; i < 8; ++i) { const float send = hb ? part[i] : part[i + 8], keep = hb ? part[i + 8] : part[i]; p8[i] = keep + __shfl_xor(send, 32); } } \
            { const bool hb = (lane & 16) != 0; _Pragma("unroll") for (int i = 0; i < 4; ++i) { const float send = hb ? p8[i] : p8[i + 4], keep = hb ? p8[i + 4] : p8[i]; p4[i] = keep + __shfl_xor(send, 16); } } \
            { const bool hb = (lane & 8) != 0; _Pragma("unroll") for (int i = 0; i < 2; ++i) { const float send = hb ? p4[i] : p4[i + 2], keep = hb ? p4[i + 2] : p4[i]; p2[i] = keep + __shfl_xor(send, 8); } } \
            { const bool hb = (lane & 4) != 0; const float send = hb ? p2[0] : p2[1], keep = hb ? p2[1] : p2[0]; p1 = keep + __shfl_xor(send, 4); } \
            p1 += dpp_xor2(p1); p1 += dpp_xor1(p1); w = GT[h * 16 + klane] * gelu_tanh(p1); } while (0)
#define PEER_PREF(s) do { constexpr int sn = (s) + 7, slotn = sn & 7; \
            if (sn < 16) PEER_ISSUE(slotn, 0, ex[sn < 16 ? sn : 0]); else if (sn < 32) PEER_ISSUE(slotn, 1, ex[(sn >= 16 && sn < 32) ? sn - 16 : 0]); else PEER_ISSUE(slotn, 0, exn[sn >= 32 ? sn - 32 : 0]); } while (0)
#define PEER_VACC(bb) do { y[c][4 * d + (bb)] = __builtin_elementwise_fma((f32x2){(float)((lo_ >> (8 * (bb))) & 0xffu), (float)((hi_ >> (8 * (bb))) & 0xffu)}, wc2[c], y[c][4 * d + (bb)]); } while (0)
#define PEER_USTEP(s) do { PEER_PREF(s); __builtin_amdgcn_sched_barrier(0); \
            { constexpr int slot = (s) & 7; float fa[2]; \
              _Pragma("unroll") for (int c = 0; c < 2; ++c) { int a_ = 0, b_ = 0; \
                _Pragma("unroll") for (int d = 0; d < 4; ++d) { a_ = __builtin_amdgcn_sdot8((int)R[slot][c][d], xq[c][d], a_, false); b_ = __builtin_amdgcn_sdot8((int)R[slot][c][d], xr[c][d], b_, false); } \
                fa[c] = fmaf((float)b_, 1.0f / 14.0f, (float)a_); } \
              part[s] = fmaf(fa[0], bflo(SCW[slot]) * sx[0], fa[1] * (bfhi(SCW[slot]) * sx[1])); asm volatile("" : "+v"(part[s])); } \
            __builtin_amdgcn_sched_barrier(0); } while (0)
#define PEER_VSTEP(s) do { PEER_PREF(s); __builtin_amdgcn_sched_barrier(0); \
            { constexpr int slot = (s) & 7, k = (s) - 16, lk = 32 * ((k >> 3) & 1) + 16 * ((k >> 2) & 1) + 8 * ((k >> 1) & 1) + 4 * (k & 1); \
              const float wk = __builtin_bit_cast(float, __builtin_amdgcn_readlane(__builtin_bit_cast(int, w), lk)); \
              const float wc[2] = {wk * bflo(SCW[slot]), wk * bfhi(SCW[slot])}; yoff[0] = fmaf(8.0f, wc[0], yoff[0]); yoff[1] = fmaf(8.0f, wc[1], yoff[1]); \
              const f32x2 wc2[2] = {(f32x2){wc[0], wc[0]}, (f32x2){wc[1], wc[1]}}; \
              _Pragma("unroll") for (int c = 0; c < 2; ++c) { _Pragma("unroll") for (int d = 0; d < 4; ++d) { unsigned rw_ = R[slot][c][d]; asm volatile("" : "+v"(rw_));        \
                  unsigned lo_ = rw_ & 0x0F0F0F0Fu, hi_ = (rw_ >> 4) & 0x0F0F0F0Fu; asm volatile("" : "+v"(lo_), "+v"(hi_)); \
                  PEER_VACC(0); PEER_VACC(1); PEER_VACC(2); PEER_VACC(3); \
                  asm volatile("" : "+v"(y[c][4 * d]), "+v"(y[c][4 * d + 1]), "+v"(y[c][4 * d + 2]), "+v"(y[c][4 * d + 3])); \
                  __builtin_amdgcn_sched_barrier(0); } } } \
            PEER_PIN_Y(); __builtin_amdgcn_sched_barrier(0); } while (0)
        PEER_USTEP(0); PEER_USTEP(1); PEER_USTEP(2); PEER_USTEP(3); PEER_USTEP(4); PEER_USTEP(5); PEER_USTEP(6); PEER_USTEP(7);
        PEER_USTEP(8); PEER_USTEP(9); PEER_USTEP(10); PEER_USTEP(11); PEER_USTEP(12); PEER_USTEP(13); PEER_USTEP(14); PEER_USTEP(15);
        PEER_RED16();
        PEER_VSTEP(16); PEER_VSTEP(17); PEER_VSTEP(18); PEER_VSTEP(19); PEER_VSTEP(20); PEER_VSTEP(21); PEER_VSTEP(22); PEER_VSTEP(23);
        PEER_VSTEP(24); PEER_VSTEP(25); PEER_VSTEP(26); PEER_VSTEP(27); PEER_VSTEP(28); PEER_VSTEP(29); PEER_VSTEP(30); PEER_VSTEP(31);
#undef PEER_USTEP
#undef PEER_VSTEP
#undef PEER_PREF
#undef PEER_VACC
#undef PEER_RED16
#undef PEER_PIN_Y
#undef PEER_PIN8
#pragma unroll
        for (int k = 0; k < 16; ++k) ex[k] = __builtin_amdgcn_readfirstlane(EX[hn * 16 + k]);
    }
#undef PEER_ISSUE
    u32x4 ha[2][4];
#pragma unroll
    for (int c = 0; c < 2; ++c)
#pragma unroll
        for (int q = 0; q < 4; ++q) ha[c][q] = *((const u32x4*)HN2 + 256 * c + 4 * lane + q);
#pragma unroll
    for (int c = 0; c < 2; ++c) { f32x4* o = (f32x4*)(orow + 2048 * c + 32 * lane);
#pragma unroll
        for (int q = 0; q < 4; ++q) { const u32x4 a = ha[c][q];
            o[2 * q] = (f32x4){bflo(a.x), bfhi(a.x), bflo(a.y), bfhi(a.y)} + ((f32x4){y[c][4 * q][0], y[c][4 * q][1], y[c][4 * q + 1][0], y[c][4 * q + 1][1]} - yoff[c]);
            o[2 * q + 1] = (f32x4){bflo(a.z), bfhi(a.z), bflo(a.w), bfhi(a.w)} + ((f32x4){y[c][4 * q + 2][0], y[c][4 * q + 2][1], y[c][4 * q + 3][0], y[c][4 * q + 3][1]} - yoff[c]); } }
    LDS_WAIT();
}

__device__ __forceinline__ unsigned enc_e4m3(float x) {
    const unsigned u = __builtin_bit_cast(unsigned, x), sign = (u >> 24) & 0x80u; const float ax = fabsf(x);
    unsigned code;
    if (ax < 0.015625f) code = (unsigned)rintf(ax * 512.0f);
    else { unsigned a = __builtin_bit_cast(unsigned, ax); a += 0x7FFFFu + ((a >> 20) & 1u); code = ((((a >> 23) - 120u) << 3) | ((a >> 20) & 7u)); }
    return sign | code;
}
constexpr int LDS_BYTES = 147456, MISC_OFF = LDS_BYTES - 256;
constexpr int CW_BAR = 1024;
static_assert((CW_BAR + XCD_BAR_WORDS) * 4 <= (int)CTL_ZERO_BYTES, "ctl");

typedef const __attribute__((address_space(4))) Ptrs* KargPtr;
__device__ __forceinline__ Ptrs load_args() {
    typedef const __attribute__((address_space(4))) unsigned long long* KW;
    Ptrs r;
#if defined(__HIP_DEVICE_COMPILE__)
    KW kp = (KW)__builtin_amdgcn_kernarg_segment_ptr(); asm volatile("" : "+s"(kp));
#define LDF(field, idx) r.field = (decltype(r.field))(GAS void*)kp[idx]
    LDF(x, 0); LDF(meta, 1); LDF(norm1_g, 2); LDF(w_in, 3); LDF(b_forget, 4); LDF(q_norm_g, 5); LDF(k_norm_g, 6); LDF(lam_re, 7); LDF(lam_im, 8); LDF(log_dt, 9);
    LDF(b_re, 10); LDF(b_im, 11); LDF(c_re, 12); LDF(c_im, 13); LDF(d_skip, 14); LDF(w_glu, 15); LDF(w_br_attn, 16); LDF(w_br_ssm, 17); LDF(w_out, 18); LDF(norm2_g, 19);
    LDF(w_query, 20); LDF(sub_keys, 21); LDF(expert_u, 22); LDF(expert_v, 23); LDF(out, 24); LDF(ws, 25);
#undef LDF
#endif
    return r;
}
__device__ __forceinline__ int fresh_lane() { int l = (int)__builtin_amdgcn_mbcnt_hi(~0u, __builtin_amdgcn_mbcnt_lo(~0u, 0u)); asm volatile("" : "+v"(l)); return l; }

__global__ void __launch_bounds__(512, 2) mega_fwd(Ptrs Punused) {
    extern __shared__ __attribute__((aligned(16))) unsigned char lds_raw[];
    LAS unsigned char* lds = (LAS unsigned char*)lds_raw;
    const int tid = threadIdx.x, wave = __builtin_amdgcn_readfirstlane(tid >> 6);
    const int G = gridDim.x, bx = blockIdx.x, vcu = (G % 8 == 0) ? (bx % 8) * (G / 8) + bx / 8 : bx;
    const int gw = bx * 8 + wave, NGW = G * 8;
    volatile LAS unsigned* MISC = (volatile LAS unsigned*)(lds + MISC_OFF);
    if (tid < 64) MISC[tid] = 0u;
    __syncthreads();
    XcdBarrier bar;
    { const Ptrs P = load_args(); bar = xcd_barrier_post((unsigned*)(P.ws + WS_CTL) + CW_BAR, MISC + 8); }

    { const Ptrs P = load_args(); const int lane = fresh_lane(); unsigned char* ws = P.ws;
      p0_prologue(P, lds, gw, NGW, wave, lane);
      if (gw < NG) s5_tables(P, gw, lane);
      f32x4 g1v[16];
#pragma unroll
      for (int j = 0; j < 16; ++j) g1v[j] = ((const f32x4*)P.norm1_g)[lane + 64 * j];
      { f32x4 va[16], vb[16];
#define RMS1_SRC(r) ((r) < NTOK ? P.x + (size_t)(r) * DM : P.meta + (size_t)((r) - NTOK) * DM)
#define RMS1_PROC(v, r) rms_row_proc(v, g1v, (bf16*)(ws + WS_HN) + (size_t)(r) * DM, lane, (r) < NTOK ? ws + WS_A8 + (size_t)(r) * DM : nullptr, (float*)(ws + WS_SA) + (r))
        int r = gw;
        if (r < NROWS) rms_row_load(va, RMS1_SRC(r), lane);
        for (; r < NROWS; r += 2 * NGW) {
            const int r1 = r + NGW, r2 = r + 2 * NGW;
            if (r1 < NROWS) rms_row_load(vb, RMS1_SRC(r1), lane);
            __builtin_amdgcn_sched_barrier(0);
            RMS1_PROC(va, r);
            __builtin_amdgcn_sched_barrier(0);
            if (r1 < NROWS) { if (r2 < NROWS) rms_row_load(va, RMS1_SRC(r2), lane); __builtin_amdgcn_sched_barrier(0); RMS1_PROC(vb, r1); __builtin_amdgcn_sched_barrier(0); }
        }
#undef RMS1_SRC
#undef RMS1_PROC
      }
      { unsigned* cmax = (unsigned*)(ws + WS_CTL) + CW_CMAX;
        for (int t = gw; t < 64 * 64; t += NGW) { const int kt = t >> 6, ct = t & 63; const float* wp = P.w_in + (size_t)(kt * 64) * NCOLS_SRC + ct * 256 + (ct >= 24 ? 16 : 0) + 4 * lane;
            f32x4 m4 = (f32x4){0.f, 0.f, 0.f, 0.f};
#pragma unroll 8
            for (int k = 0; k < 64; ++k) { const f32x4 w = *(const f32x4*)(wp + (size_t)k * NCOLS_SRC); m4[0] = fmaxf(m4[0], fabsf(w[0])); m4[1] = fmaxf(m4[1], fabsf(w[1])); m4[2] = fmaxf(m4[2], fabsf(w[2])); m4[3] = fmaxf(m4[3], fabsf(w[3])); }
#pragma unroll
            for (int e = 0; e < 4; ++e) atomicMax(cmax + ct * 256 + 4 * lane + e, __builtin_bit_cast(unsigned, m4[e])); }
        unsigned* cm2 = (unsigned*)(ws + WS_CTL) + CW_CMAX2;
        for (int t = gw; t < 2048; t += NGW) {
            if (t < 512) absmax_tile(P.w_br_attn + (t & 15) * 256, DM, (t >> 4) * 64, cm2 + (t & 15) * 256, lane);
            else if (t < 1024) absmax_tile(P.w_br_ssm + ((t - 512) & 15) * 256, DM, ((t - 512) >> 4) * 64, cm2 + 4096 + ((t - 512) & 15) * 256, lane);
            else absmax_tile(P.w_out + ((t - 1024) & 15) * 256, DM, ((t - 1024) >> 4) * 64, cm2 + 8192 + ((t - 1024) & 15) * 256, lane); } } }
    xcd_barrier(bar);

    { const Ptrs P = load_args(); const int lane = fresh_lane(); unsigned char* ws = P.ws;
      p1_prelude(P, gw, NGW, lane);
      { LAS float* scr = (LAS float*)(lds + wave * 16640); const unsigned* cmax = (const unsigned*)(ws + WS_CTL) + CW_CMAX;
        for (int t = gw; t < 64 * 256; t += NGW) tr_tile_i8(P.w_in, (t & 255) * 64, (t >> 8) * 64, ws + WS_W8, cmax, (float*)(ws + WS_SW), scr, lane);
        const unsigned* cm2 = (const unsigned*)(ws + WS_CTL) + CW_CMAX2; float* sw2 = (float*)(ws + WS_SW2);
        constexpr int NPRE = NROWS / 16 + (3 * 2048) / 16;
        const int nfree = NGW > NPRE ? NGW - NPRE : 0, nq8a = nfree * 8 < 8192 ? nfree * 8 : 8192;
        for (int j = 0; j < 8192; ++j) {
            int t;
            if (gw >= NPRE) { if (j >= 8) break; t = (gw - NPRE) * 8 + j; if (t >= nq8a) break; }
            else { t = nq8a + gw + j * (NGW < NPRE ? NGW : NPRE); if (t >= 8192) break; }
            if (t < 2048) tr_tile_q8(P.w_br_attn, DM, (t & 63) * 64, (t >> 6) * 64, ws + WS_WAB, DM, 0, (t & 63) * 64, cm2, sw2, scr, lane);
            else if (t < 4096) tr_tile_q8(P.w_br_ssm, DM, (t & 63) * 64, ((t - 2048) >> 6) * 64, ws + WS_WAB, DM, SSMW, (t & 63) * 64, cm2 + 4096, sw2 + 4096, scr, lane);
            else tr_tile_q8(P.w_out, DM, (t & 63) * 64, ((t - 4096) >> 6) * 64, ws + WS_WOUT, DM, 0, (t & 63) * 64, cm2 + 8192, sw2 + 8192, scr, lane); } } }
    xcd_barrier(bar);
    { const Ptrs P = load_args(); unsigned char* ws = P.ws;
      pg8::Gemm g{(const bf16*)(ws + WS_A8), (const bf16*)(ws + WS_W8), DM / 2, DM / 2, DM / 2}; pg8::StaticOrder S; S.init(NTOK, 16384, G, bx);
      Epi1 E{(bf16*)(ws + WS_Q), (bf16*)(ws + WS_K), (bf16*)(ws + WS_V), (bf16*)(ws + WS_U), (bf16*)(ws + WS_GA), (bf16*)(ws + WS_GB), (const float*)(ws + WS_SA), (const float*)(ws + WS_SW), P.q_norm_g, P.k_norm_g, (PG8_LAS float*)(lds + pg8::STAGE_BYTES)};
      pg8::gemm_phase<Epi1, pg8::StaticOrder, true, true>(lds, g, S, E); }
    xcd_barrier(bar);

    { const Ptrs P = load_args(); const int lane = fresh_lane();
      const int rgw = NGW - 1 - gw;
      if (rgw < NB * NH) p2_cumsum(P, rgw, lane);
      p2_qknorm_zero(P, rgw, NGW, lane);
      for (int u = gw; u < NB * NG * (NCH - 1); u += NGW) { const int ch = u % (NCH - 1), bg = u / (NCH - 1); s5_unit<false>(P, bg / NG, bg % NG, ch, (LAS float*)(lds + wave * 12800), (LAS unsigned*)(lds + wave * 12800 + 8448), lane); } }
    xcd_barrier(bar);

    { const Ptrs P = load_args(); attn_phase(P, (char*)lds_raw, vcu, G); }
    __syncthreads();
    { const Ptrs P = load_args(); const int lane = fresh_lane();
      for (int u = gw; u < NB * NG * NCH; u += NGW) { const int ch = u % NCH, bg = u / NCH;
        s5_unit<true>(P, bg / NG, bg % NG, ch, (LAS float*)(lds + wave * 12800), (LAS unsigned*)(lds + wave * 12800 + 8448), lane); } }
    xcd_barrier(bar);

    { const Ptrs P = load_args(); unsigned char* ws = P.ws;
      pg8::Gemm g{(const bf16*)(ws + WS_Z), (const bf16*)(ws + WS_WGLU), SSMW, SSMW, SSMW}; pg8::StaticOrder S; S.init(NTOK, SSMW, G, bx);
      EpiGlu E{(const bf16*)(ws + WS_Z), (bf16*)(ws + WS_AS)};
      pg8::gemm_phase<EpiGlu, pg8::StaticOrder, true>(lds, g, S, E); }
    xcd_barrier(bar);

    { const Ptrs P = load_args(); const int lane = fresh_lane(); unsigned char* ws = P.ws;
      { u32x4 ra[8], rb[8]; int r = gw;
        if (r < NTOK) rowq8_load(ra, (const bf16*)(ws + WS_AS) + (size_t)r * DM, lane);
        for (; r < NTOK; r += 2 * NGW) { const int r1 = r + NGW, r2 = r + 2 * NGW;
            if (r1 < NTOK) rowq8_load(rb, (const bf16*)(ws + WS_AS) + (size_t)r1 * DM, lane);
            __builtin_amdgcn_sched_barrier(0);
            rowq8<true>(ra, ws + WS_AS8 + (size_t)r * DM, (float*)(ws + WS_SA2) + r, lane);
            __builtin_amdgcn_sched_barrier(0);
            if (r1 < NTOK) { if (r2 < NTOK) rowq8_load(ra, (const bf16*)(ws + WS_AS) + (size_t)r2 * DM, lane); __builtin_amdgcn_sched_barrier(0);
                rowq8<true>(rb, ws + WS_AS8 + (size_t)r1 * DM, (float*)(ws + WS_SA2) + r1, lane); __builtin_amdgcn_sched_barrier(0); } } } }
    xcd_barrier(bar);

    { const Ptrs P = load_args(); unsigned char* ws = P.ws;
      pg8::Gemm g{(const bf16*)(ws + WS_AS8), (const bf16*)(ws + WS_WAB), DM / 2, DM / 2, ATTW / 2}; pg8::StaticOrder S; S.init(NTOK, DM, G, bx);
      EpiBrA E{(const bf16*)(ws + WS_GA), (bf16*)(ws + WS_HN), (const float*)(ws + WS_SA2), (const float*)(ws + WS_SW2)};
      pg8::gemm_phase<EpiBrA, pg8::StaticOrder, true, true>(lds, g, S, E); }
    asm volatile("s_waitcnt vmcnt(0)" ::: "memory"); __syncthreads();

    { const Ptrs P = load_args(); unsigned char* ws = P.ws;
      pg8::Gemm g{(const bf16*)(ws + WS_AS8 + SSMW), (const bf16*)(ws + WS_WAB + SSMW), DM / 2, DM / 2, SSMW / 2}; pg8::StaticOrder S; S.init(NTOK, DM, G, bx);
      EpiBrB E{(const bf16*)(ws + WS_GB), (const bf16*)(ws + WS_HN), (bf16*)(ws + WS_U), (const float*)(ws + WS_SA2) + NTOK, (const float*)(ws + WS_SW2) + 4096};
      pg8::gemm_phase<EpiBrB, pg8::StaticOrder, true, true>(lds, g, S, E); }
    xcd_barrier(bar);

    { const Ptrs P = load_args(); const int lane = fresh_lane(); unsigned char* ws = P.ws;
      { u32x4 ra[8], rb[8]; int r = gw;
        if (r < NTOK) rowq8_load(ra, (const bf16*)(ws + WS_U) + (size_t)r * DM, lane);
        for (; r < NTOK; r += 2 * NGW) { const int r1 = r + NGW, r2 = r + 2 * NGW;
            if (r1 < NTOK) rowq8_load(rb, (const bf16*)(ws + WS_U) + (size_t)r1 * DM, lane);
            __builtin_amdgcn_sched_barrier(0);
            rowq8<false>(ra, ws + WS_MIX8 + (size_t)r * DM, (float*)(ws + WS_SA2) + 2 * NTOK + r, lane);
            __builtin_amdgcn_sched_barrier(0);
            if (r1 < NTOK) { if (r2 < NTOK) rowq8_load(ra, (const bf16*)(ws + WS_U) + (size_t)r2 * DM, lane); __builtin_amdgcn_sched_barrier(0);
                rowq8<false>(rb, ws + WS_MIX8 + (size_t)r1 * DM, (float*)(ws + WS_SA2) + 2 * NTOK + r1, lane); __builtin_amdgcn_sched_barrier(0); } } }
      for (int row = gw; row < 2 * PEER_N; row += NGW) {
          const bool isv = row >= PEER_N;
          const float* src = !isv ? P.expert_u + (size_t)row * DM : P.expert_v + (size_t)(row - PEER_N) * DM;
          f32x4 v[16];
#pragma unroll
          for (int j = 0; j < 16; ++j) v[j] = ((const f32x4*)src)[lane + 64 * j];
          if (!isv) {
#pragma unroll
              for (int j = 0; j < 16; ++j) v[j] = v[j] * ((const f32x4*)P.norm2_g)[lane + 64 * j]; }
          unsigned short* dst = (unsigned short*)(ws + WS_E4 + (size_t)row * E4ROW) + lane;
          bf16* sdst = (bf16*)(ws + WS_E4 + (size_t)row * E4ROW + 2048);
          const int bias = isv ? 8 : 0;
          float amv[16];
#pragma unroll
          for (int j = 0; j < 16; ++j) { amv[j] = fmaxf(fmaxf(fabsf(v[j][0]), fabsf(v[j][1])), fmaxf(fabsf(v[j][2]), fabsf(v[j][3]))); amv[j] = fmaxf(amv[j], dpp_xor1(amv[j])); amv[j] = fmaxf(amv[j], dpp_xor2(amv[j])); }
#pragma unroll
          for (int j = 0; j < 16; ++j) amv[j] = fmaxf(amv[j], __shfl_xor(amv[j], 4));
#pragma unroll
          for (int j = 0; j < 16; ++j) amv[j] = fmaxf(amv[j], __shfl_xor(amv[j], 8));
#pragma unroll
          for (int j = 0; j < 16; ++j) {
              const float am = amv[j];
              const unsigned sb = am > 0.f ? f2bf(am * (1.0f / 7.0f)) : 0x3f80u;
              const float inv = 1.0f / __builtin_bit_cast(float, sb << 16);
              unsigned wv = 0u;
#pragma unroll
              for (int e = 0; e < 4; ++e) { const int qv = (int)fminf(fmaxf(rintf(v[j][e] * inv), -7.f), 7.f) + bias; wv |= ((unsigned)qv & 15u) << (4 * e); }
              dst[64 * j] = (unsigned short)wv;
              if ((lane & 15) == 0) { const int blk = 4 * j + (lane >> 4); sdst[(blk & 31) * 2 + (blk >> 5)] = (bf16)sb; }
          }
      } }
    xcd_barrier(bar);

    { const Ptrs P = load_args(); unsigned char* ws = P.ws;
      pg8::Gemm g{(const bf16*)(ws + WS_MIX8), (const bf16*)(ws + WS_WOUT), DM / 2, DM / 2, DM / 2}; pg8::StaticOrder S; S.init(NTOK, DM, G, bx);
      EpiOut E{P.x, (const float*)(ws + WS_SA2) + 2 * NTOK, (const float*)(ws + WS_SW2) + 8192, (bf16*)(ws + WS_HN), (float*)(ws + WS_PSS), (PG8_LAS float*)(lds + pg8::STAGE_BYTES)};
      pg8::gemm_phase<EpiOut, pg8::StaticOrder, true, true>(lds, g, S, E); }
    xcd_barrier(bar);

    { const Ptrs P = load_args(); unsigned char* ws = P.ws;
      pg8::Gemm g{(const bf16*)(ws + WS_HN), (const bf16*)(ws + WS_WQ), DM, DM, DM}; pg8::StaticOrder S; S.init(NTOK, PEER_QW, G, bx);
      EpiQP E{(float*)(ws + WS_GA), (const float*)(ws + WS_PSS)};
      pg8::gemm_phase<EpiQP, pg8::StaticOrder, true>(lds, g, S, E); }
    xcd_barrier(bar);

    { const Ptrs P = load_args(); const int lane = fresh_lane(); LAS unsigned char* wl = lds + wave * 12288;
      LAS float* TV = (LAS float*)wl; LAS int* TI = (LAS int*)(wl + 1024);
#define PEER_EXB(i) ((LAS int*)(wl + 2048 + (i) * 1024))
#define PEER_GTB(i) ((LAS float*)(wl + 2560 + (i) * 1024))
      u32x4 R[8][2]; unsigned SCW[8];
      int cur = 0; bool first = true;
      if (gw < NTOK) peer_select(P, gw, TV, TI, PEER_EXB(0), PEER_GTB(0), lane);
      for (int tok = gw; tok < NTOK; tok += NGW) { const int nxt = tok + NGW;
          if (nxt < NTOK) peer_select(P, nxt, TV, TI, PEER_EXB(cur ^ 1), PEER_GTB(cur ^ 1), lane);
          peer_gather(P, tok, PEER_EXB(cur), PEER_GTB(cur), nxt < NTOK ? PEER_EXB(cur ^ 1) : PEER_EXB(cur), first, R, SCW, lane);
          first = false; cur ^= 1; }
#undef PEER_EXB
#undef PEER_GTB
    }
}

extern "C" void kernel_launch(void* const* d_in, const int* in_sizes, int n_in, void* d_out, int out_size, void* d_ws, size_t ws_size, hipStream_t stream) {
    static int grid = 0;
    if (grid == 0) {
        if (n_in != 24 || out_size != NTOK * DM || ws_size < WS_END) { fprintf(stderr, "kernel_launch: unexpected shapes (n_in %d out %d ws %zu)\n", n_in, out_size, ws_size); grid = -1; return; }
        int dev = 0, cus = 0, per_cu = 0;
        if (hipGetDevice(&dev) != hipSuccess || hipDeviceGetAttribute(&cus, hipDeviceAttributeMultiprocessorCount, dev) != hipSuccess) { grid = -1; return; }
        if (hipFuncSetAttribute((const void*)mega_fwd, hipFuncAttributeMaxDynamicSharedMemorySize, LDS_BYTES) != hipSuccess) { grid = -1; return; }
        if (hipOccupancyMaxActiveBlocksPerMultiprocessor(&per_cu, (const void*)mega_fwd, 512, LDS_BYTES) != hipSuccess || per_cu < 1) fprintf(stderr, "kernel_launch: occupancy query says %d\n", per_cu);
        (void)hipGetLastError();
        grid = cus;
    }
    if (grid < 0) return;
    if (hipMemsetAsync((char*)d_ws + WS_CTL, 0, CTL_ZERO_BYTES, stream) != hipSuccess) return;
    Ptrs p{};
    const float** f = (const float**)&p;
    for (int i = 0; i < 24; ++i) f[i] = (const float*)d_in[i];
    p.out = (float*)d_out; p.ws = (unsigned char*)d_ws;
    hipLaunchKernelGGL(mega_fwd, dim3(grid), dim3(512), LDS_BYTES, stream, p);
}
```

```cpp
#include <hip/hip_runtime.h>
#include <cstdio>
#include <cstdint>
#include <hip/hip_bf16.h>

#define GAS __attribute__((address_space(1)))
#define LAS __attribute__((address_space(3)))
typedef unsigned short bf16;
typedef unsigned short bf16_t;
typedef short bf16x8 __attribute__((ext_vector_type(8)));
typedef short s16x4 __attribute__((ext_vector_type(4)));
typedef float f32x2 __attribute__((ext_vector_type(2)));
typedef float f32x4 __attribute__((ext_vector_type(4)));
typedef float f32x16 __attribute__((ext_vector_type(16)));
typedef unsigned u32x2 __attribute__((ext_vector_type(2)));
typedef unsigned u32x4 __attribute__((ext_vector_type(4)));
typedef GAS unsigned gu32;

constexpr int NB = 4, SEQ = 4096, DM = 4096, NTOK = NB * SEQ;
constexpr int NMETA = 16, NROWS = NTOK + NMETA;
constexpr int NH = 16, HD = 128, ATTW = NH * HD;
constexpr int KVPAD = 64, SKV = KVPAD + SEQ;
constexpr int NG = 128, GC = 16, NS = 64, SSMW = NG * GC;
constexpr int NCOLS_SRC = 16400;
constexpr int C_Q = 0, C_K = 2048, C_V = 4096, C_U = 6144, C_GA = 8192, C_GB = 12288, C_F = 16384, NW1 = 16400;
constexpr int PEER_H = 8, PEER_K = 128, PEER_TOPK = 16, PEER_QW = 2048, PEER_N = 16384;
constexpr float EPS = 1e-6f;
constexpr int NCH = 8, LCH = SEQ / NCH;

constexpr size_t MiB = 1u << 20;
constexpr size_t WS_CTL = 0, CTL_ZERO_BYTES = 192 * 1024;
constexpr size_t WS_LOGF = 1 * MiB;
constexpr size_t WS_BIAS = 3 * MiB;
constexpr size_t WS_S5E  = 5 * MiB;
constexpr size_t WS_PSS  = 5 * MiB;
constexpr size_t WS_UMETA = 7 * MiB;
constexpr size_t WS_KT = 7 * MiB + 512 * 1024;
constexpr size_t WS_WT1 = 8 * MiB;
constexpr size_t WS_Z = 8 * MiB;
constexpr size_t WS_WGLU = 137 * MiB;
constexpr size_t WS_WAB = 145 * MiB;
constexpr size_t WS_WOUT = 177 * MiB;
constexpr size_t WS_WQ = 209 * MiB;
constexpr size_t WS_HN = 225 * MiB;
constexpr size_t WS_Q = 354 * MiB;
constexpr size_t WS_K = 418 * MiB;
constexpr size_t WS_V = 484 * MiB;
constexpr size_t WS_U = 549 * MiB;
constexpr size_t WS_GA = 677 * MiB;
constexpr size_t WS_GB = 805 * MiB;
constexpr size_t WS_AS = 933 * MiB;
constexpr size_t WS_E4 = 354 * MiB;
constexpr size_t E4ROW = 2176;
constexpr size_t WS_E4S = 418 * MiB;
constexpr size_t WS_S5T = 1061 * MiB;
constexpr size_t S5T_AT = 0, S5T_BFR = 64 * 1024, S5T_CFR = S5T_BFR + 1024 * 1024;
constexpr size_t WS_A8 = 1063 * MiB;
constexpr size_t WS_W8 = 1127 * MiB;
constexpr size_t WS_SA = 1191 * MiB;
constexpr size_t WS_SW = 1191 * MiB + 65536;
constexpr size_t WS_SA2 = 1191 * MiB + 131072;
constexpr size_t WS_SW2 = 1191 * MiB + 327680;
constexpr size_t WS_AS8 = 1063 * MiB;
constexpr size_t WS_MIX8 = 1127 * MiB;
constexpr size_t WS_END = 1192 * MiB;
constexpr int CW_CMAX2 = 32768;
constexpr int CW_CMAX = 16384;

#define LDS_WAIT() asm volatile("s_waitcnt lgkmcnt(0)" ::: "memory")
#define VM_WAIT() asm volatile("s_waitcnt vmcnt(0)" ::: "memory")
__device__ __forceinline__ unsigned f2bf(float f) { unsigned u = __builtin_bit_cast(unsigned, f); return (u + 0x7fffu + ((u >> 16) & 1u)) >> 16; }
typedef __bf16 bf16x2_t __attribute__((ext_vector_type(2)));
__device__ __forceinline__ unsigned pk2(float lo, float hi) { const f32x2 v = {lo, hi}; return __builtin_bit_cast(unsigned, __builtin_convertvector(v, bf16x2_t)); }
__device__ __forceinline__ float bflo(unsigned w) { return __builtin_bit_cast(float, w << 16); }
__device__ __forceinline__ float bfhi(unsigned w) { return __builtin_bit_cast(float, w & 0xffff0000u); }
__device__ __forceinline__ float wave_sum(float v) {
#pragma unroll
    for (int o = 1; o < 64; o <<= 1) v += __shfl_xor(v, o);
    return v;
}
__device__ __forceinline__ float sigmoidf_(float v) { return __builtin_amdgcn_rcpf(1.f + __expf(-v)); }
__device__ __forceinline__ float gelu_tanh(float x) { const float a = 1.5957691216057308f * (x + 0.044715f * x * x * x); return x * sigmoidf_(a); }
#define XB_TMO      128
#define XB_XCNT(j)  (256  + 64 * (j))
#define XB_XSUB(j)  (1280 + 64 * (j))
#define XB_XGEN(j)  (2304 + 64 * (j))
#define XB_TOP      3328
#define XB_TOPGEN   3392
#define XCD_BAR_WORDS 3456
#define XB_SPIN_CAP (1u << 18)

__device__ __forceinline__ unsigned xb_ld(unsigned* p)              { return __hip_atomic_load(p, __ATOMIC_RELAXED, __HIP_MEMORY_SCOPE_AGENT); }
__device__ __forceinline__ unsigned xb_add(unsigned* p, unsigned v) { return __hip_atomic_fetch_add(p, v, __ATOMIC_RELAXED, __HIP_MEMORY_SCOPE_AGENT); }
__device__ __forceinline__ unsigned xb_xcc_id() { return (unsigned)__builtin_amdgcn_s_getreg((3 << 11) | 20) & 0xFu; }
#define XB_SPIN(cond, bar) do { unsigned _sp = 0; while (cond) { __builtin_amdgcn_s_sleep(1); \
    if ((++_sp & 255u) == 0u) { if (xb_ld(&(bar)[XB_TMO])) break; if (_sp > XB_SPIN_CAP) { atomicAdd(&(bar)[XB_TMO], 1u); break; } } } } while (0)

struct XcdBarrier {
    unsigned* bar; unsigned x;
    volatile LAS unsigned* st;
};

__device__ __forceinline__ XcdBarrier xcd_barrier_post(unsigned* bar, volatile LAS unsigned* st) {
    XcdBarrier b; b.bar = bar; b.x = xb_xcc_id(); b.st = st;
    if (threadIdx.x == 0) (void)xb_add(&bar[XB_XCNT(b.x)], 1u);
    return b;
}
__device__ __forceinline__ void xcd_barrier_complete(unsigned* bar, unsigned x, unsigned& nloc, unsigned& nx) {
    const unsigned G = gridDim.x * gridDim.y * gridDim.z;
    unsigned sum, cnt, mine, sp = 0u;
    for (;;) {
        sum = 0u; cnt = 0u; mine = 0u;
#pragma unroll
        for (unsigned j = 0; j < 16; ++j) { const unsigned c = xb_ld(&bar[XB_XCNT(j)]); sum += c; cnt += (c > 0u) ? 1u : 0u; mine = (j == x) ? c : mine; }
        if (sum == G) break;
        __builtin_amdgcn_s_sleep(1);
        if ((++sp & 255u) == 0u) { if (xb_ld(&bar[XB_TMO])) break; if (sp > XB_SPIN_CAP) { atomicAdd(&bar[XB_TMO], 1u); break; } }
    }
    nloc = mine > 0u ? mine : 1u; nx = cnt > 0u ? cnt : 1u;
}

__device__ __forceinline__ void xcd_barrier(const XcdBarrier& b) {
    asm volatile("s_waitcnt vmcnt(0)" ::: "memory");
    __syncthreads();
    if (threadIdx.x == 0) {
        unsigned* bar = b.bar;
        __builtin_amdgcn_s_waitcnt(0);
        unsigned nloc = b.st[0], nx = b.st[1];
        if (nloc == 0u) { xcd_barrier_complete(bar, b.x, nloc, nx); b.st[0] = nloc; b.st[1] = nx; }
        const unsigned old = xb_add(&bar[XB_XSUB(b.x)], 1u);
        const unsigned gen = old / nloc;
        if (old + 1u == (gen + 1u) * nloc) {
            __builtin_amdgcn_fence(__ATOMIC_RELEASE, "agent");
            asm volatile("s_waitcnt vmcnt(0)" ::: "memory");
            const unsigned og = xb_add(&bar[XB_TOP], 1u);
            const unsigned tg = og / nx;
            if (og + 1u == (tg + 1u) * nx) xb_add(&bar[XB_TOPGEN], 1u);
            else XB_SPIN(xb_ld(&bar[XB_TOPGEN]) == tg, bar);
            __builtin_amdgcn_fence(__ATOMIC_ACQUIRE, "agent");
            xb_add(&bar[XB_XGEN(b.x)], 1u);
            asm volatile("s_waitcnt vmcnt(0)" ::: "memory");
        } else {
            XB_SPIN(xb_ld(&bar[XB_XGEN(b.x)]) == gen, bar);
            __builtin_amdgcn_fence(__ATOMIC_ACQUIRE, "agent");
            asm volatile("s_waitcnt vmcnt(0)" ::: "memory");
        }
    }
    __syncthreads();
}
namespace pg8 {
#define PG8_LAS __attribute__((address_space(3)))
constexpr int BM = 256, BK = 64, HALF = 128, HTB = HALF * BK * 2  , STAGE_BYTES = 8 * HTB, NXCD = 8, WGM = 8;
__host__ __device__ __forceinline__ int lds_byte(int r, int c) { const int st = (r >> 4) * 2 + (c >> 5), rr = r & 15, cc = c & 31, ob = rr * 64 + cc * 2; return st * 1024 + (ob ^ (((ob >> 9) & 1) << 5)); }
__host__ __device__ __forceinline__ void stage_rc(int b, int& R, int& C) { const int st = b / 1024, sb = b % 1024, swz = sb ^ (((sb >> 9) & 1) << 5); R = (st >> 1) * 16 + swz / 64; C = (st & 1) * 32 + (swz % 64) / 2; }
__host__ __device__ __forceinline__ int perm32(int rho) { const int n = rho >> 4, i = rho & 15; return 8 * (i >> 2) + 4 * n + (i & 3); }
typedef int i32x4g __attribute__((ext_vector_type(4)));
struct Unit { int pm, pn; };
struct Gemm { const bf16_t* A; const bf16_t* Bt; int lda, ldb, K; };
struct StaticOrder {
    int nM, nN, nwg, G, c;
    __host__ __device__ void init(int M, int N, int G_, int c_) { nM = M / BM; nN = N / BM; nwg = nM * nN; G = G_; c = c_; }
    __host__ __device__ bool next(int i, Unit& u) const {
        const long L = (long)i * G + c; if (L >= nwg) return false;
        int wgid = (int)L; { const int q = nwg / NXCD, r = nwg % NXCD, xcd = wgid % NXCD, off = wgid / NXCD; wgid = (xcd < r ? xcd * (q + 1) : r * (q + 1) + (xcd - r) * q) + off; }
        const int nig = WGM * nN, gid = wgid / nig, fm = gid * WGM, gsz = (nM - fm) < WGM ? (nM - fm) : WGM;
        u.pm = fm + ((wgid % nig) % gsz); u.pn = (wgid % nig) / gsz; return true;
    }
};
template <class Epi, class Sched, bool ALIGN_EPI, bool I8 = false>
__device__ __forceinline__ void gemm_phase(PG8_LAS unsigned char* lds, const Gemm g, const Sched& S, const Epi& E) {
    int tid = threadIdx.x; asm volatile("" : "+v"(tid));
    const int wid = __builtin_amdgcn_readfirstlane(tid >> 6), lane = tid & 63, wr = wid >> 2, wc = wid & 3, fr = lane & 15, fq = lane >> 4;
    const int K = g.K, nt = K / BK;
    unsigned voffA[2], voffB[2];
#pragma unroll
    for (int i = 0; i < 2; ++i) { int R, C; stage_rc(tid * 16 + i * 8192, R, C); const int Rb = (R & ~31) + perm32(R & 31);
        voffA[i] = (unsigned)(R * g.lda + C) * 2u; voffB[i] = (unsigned)(Rb * g.ldb + C) * 2u; }
    const size_t kstep = (size_t)(BK * 2);
    const size_t hstepA = (size_t)HALF * g.lda * 2, hstepB = (size_t)HALF * g.ldb * 2;
    const size_t tstepA = 2 * hstepA, tstepB = 2 * hstepB;
    const unsigned ldsw = (unsigned)wid * 1024u;
    const int aoff = lds_byte(wr * 64 + fr, fq * 8), boff = lds_byte(wc * 32 + fr, fq * 8);
#define PG8_SA(b, h) (((b) * 2 + (h)) * HTB)
#define PG8_SB(b, h) ((4 + (b) * 2 + (h)) * HTB)
#define PG8_STAGE(bufoff, gbase, voff) do { _Pragma("unroll") for (int _i = 0; _i < 2; ++_i) \
        __builtin_amdgcn_global_load_lds((const unsigned*)((const char*)(gbase) + (voff)[_i]), (PG8_LAS unsigned*)(lds + (bufoff) + ldsw + _i * 8192), 16, 0, 0); } while (0)
#define PG8_LDA(dst, b, h) do { _Pragma("unroll") for (int m = 0; m < 4; ++m) _Pragma("unroll") for (int k = 0; k < 2; ++k) dst[m][k] = *(const PG8_LAS bf16x8*)(lds + PG8_SA(b, h) + aoff + m * 2048 + k * 1024); } while (0)
#define PG8_LDB(dst, b, h) do { _Pragma("unroll") for (int n = 0; n < 2; ++n) _Pragma("unroll") for (int k = 0; k < 2; ++k) dst[n][k] = *(const PG8_LAS bf16x8*)(lds + PG8_SB(b, h) + boff + n * 2048 + k * 1024); } while (0)
#define PG8_MMA(ai, bj, At, Bt) do { __builtin_amdgcn_s_setprio(1); _Pragma("unroll") for (int m = 0; m < 4; ++m) _Pragma("unroll") for (int n = 0; n < 2; ++n) _Pragma("unroll") for (int k = 0; k < 2; ++k) { \
        if constexpr (I8) acc[ai][bj][m][n] = __builtin_bit_cast(f32x4, __builtin_amdgcn_mfma_i32_16x16x64_i8(__builtin_bit_cast(i32x4g, Bt[n][k]), __builtin_bit_cast(i32x4g, At[m][k]), __builtin_bit_cast(i32x4g, acc[ai][bj][m][n]), 0, 0, 0)); \
        else acc[ai][bj][m][n] = __builtin_amdgcn_mfma_f32_16x16x32_bf16(Bt[n][k], At[m][k], acc[ai][bj][m][n], 0, 0, 0); } __builtin_amdgcn_s_setprio(0); } while (0)
#define PG8_WAIT_V(n) asm volatile("s_waitcnt vmcnt(" #n ")" ::: "memory")
#define PG8_WAIT_L(n) asm volatile("s_waitcnt lgkmcnt(" #n ")" ::: "memory")
#define PG8_BAR __builtin_amdgcn_s_barrier()
#define PG8_SCHED __builtin_amdgcn_sched_barrier(0)
    Unit cur, nxt; int ui = 0;
    if (!S.next(0, cur)) return;
    f32x4 acc[2][2][4][2];
#pragma unroll
    for (int a = 0; a < 2; ++a)
#pragma unroll
        for (int b = 0; b < 2; ++b)
#pragma unroll
            for (int m = 0; m < 4; ++m)
#pragma unroll
                for (int n = 0; n < 2; ++n) acc[a][b][m][n] = (f32x4){0.f, 0.f, 0.f, 0.f};
    bf16x8 At[4][2], B0[2][2], B1[2][2];
    const char* cA = (const char*)g.A + (size_t)cur.pm * tstepA; const char* cB = (const char*)g.Bt + (size_t)cur.pn * tstepB;
    PG8_STAGE(PG8_SB(0, 0), cB, voffB); PG8_STAGE(PG8_SB(0, 1), cB + hstepB, voffB); PG8_STAGE(PG8_SA(0, 0), cA, voffA); PG8_STAGE(PG8_SA(0, 1), cA + hstepA, voffA);
    if (wr == 1) PG8_BAR;
    PG8_WAIT_V(2); PG8_BAR;
    PG8_STAGE(PG8_SB(1, 0), cB + kstep, voffB); PG8_STAGE(PG8_SA(1, 0), cA + kstep, voffA); PG8_STAGE(PG8_SB(1, 1), cB + hstepB + kstep, voffB);
    PG8_WAIT_V(6); PG8_BAR;
    for (;;) {
        const bool has_next = S.next(ui + 1, nxt);
        const char* nA = has_next ? (const char*)g.A + (size_t)nxt.pm * tstepA : cA; const char* nB = has_next ? (const char*)g.Bt + (size_t)nxt.pn * tstepB : cB;
        for (int t = 0; t < nt; t += 2) {
            const bool last = (t == nt - 2);
            const char* a1 = cA + (size_t)(t + 1) * kstep;
            const char* a2 = last ? nA : cA + (size_t)(t + 2) * kstep; const char* b2 = last ? nB : cB + (size_t)(t + 2) * kstep;
            const char* a3 = a2 + kstep; const char* b3 = b2 + kstep;
            PG8_LDB(B0, 0, 0); PG8_LDB(B1, 0, 1); PG8_SCHED; PG8_LDA(At, 0, 0); PG8_STAGE(PG8_SA(1, 1), a1 + hstepA, voffA);
            PG8_WAIT_V(8); PG8_WAIT_L(0); PG8_BAR; PG8_MMA(0, 0, At, B0); PG8_MMA(0, 1, At, B1); PG8_BAR; PG8_SCHED;
            PG8_LDA(At, 0, 1); PG8_STAGE(PG8_SB(0, 0), b2, voffB); PG8_STAGE(PG8_SB(0, 1), b2 + hstepB, voffB); PG8_STAGE(PG8_SA(0, 0), a2, voffA);
            PG8_WAIT_V(8); PG8_WAIT_L(0); PG8_BAR; PG8_MMA(1, 0, At, B0); PG8_MMA(1, 1, At, B1); PG8_BAR; PG8_SCHED;
            PG8_LDB(B0, 1, 0); PG8_LDB(B1, 1, 1); PG8_SCHED; PG8_LDA(At, 1, 0); PG8_STAGE(PG8_SA(0, 1), a2 + hstepA, voffA);
            PG8_WAIT_V(8); PG8_WAIT_L(0); PG8_BAR; PG8_MMA(0, 0, At, B0); PG8_MMA(0, 1, At, B1); PG8_BAR; PG8_SCHED;
            PG8_LDA(At, 1, 1); PG8_STAGE(PG8_SB(1, 0), b3, voffB); PG8_STAGE(PG8_SB(1, 1), b3 + hstepB, voffB); PG8_STAGE(PG8_SA(1, 0), a3, voffA);
            PG8_WAIT_V(8); PG8_WAIT_L(0); PG8_BAR; PG8_MMA(1, 0, At, B0); PG8_MMA(1, 1, At, B1); PG8_BAR; PG8_SCHED;
        }
        if constexpr (ALIGN_EPI) { if (wr == 0) PG8_BAR; }
        E(acc, cur, wr, wc, fr, fq);
        if (!has_next) break;
#pragma unroll
        for (int a = 0; a < 2; ++a)
#pragma unroll
            for (int b = 0; b < 2; ++b)
#pragma unroll
                for (int m = 0; m < 4; ++m)
#pragma unroll
                    for (int n = 0; n < 2; ++n) acc[a][b][m][n] = (f32x4){0.f, 0.f, 0.f, 0.f};
        cur = nxt; cA = nA; cB = nB; ++ui;
        if constexpr (ALIGN_EPI) { if (wr == 1) PG8_BAR; }
    }
    PG8_WAIT_V(0);
    if constexpr (!ALIGN_EPI) { if (wr == 0) PG8_BAR; }
    PG8_BAR;
#undef PG8_SA
#undef PG8_SB
#undef PG8_STAGE
#undef PG8_LDA
#undef PG8_LDB
#undef PG8_MMA
#undef PG8_WAIT_V
#undef PG8_WAIT_L
#undef PG8_BAR
#undef PG8_SCHED
}
}
typedef f32x4 Acc[2][2][4][2];
typedef int i32x4q __attribute__((ext_vector_type(4)));
__device__ __forceinline__ f32x4 deq4v(f32x4 accbits, f32x4 s, float sa) { const i32x4q i = __builtin_bit_cast(i32x4q, accbits); return (f32x4){(float)i[0], (float)i[1], (float)i[2], (float)i[3]} * s * sa; }
__device__ __forceinline__ f32x4 deq4(f32x4 accbits, const float* sw, float sa) { const i32x4q i = __builtin_bit_cast(i32x4q, accbits); const f32x4 s = *(const f32x4*)sw;
    return (f32x4){(float)i[0], (float)i[1], (float)i[2], (float)i[3]} * s * sa; }
__device__ __forceinline__ u32x4 pack8bf(f32x4 a, f32x4 b) { u32x4 w; w.x = pk2(a[0], a[1]); w.y = pk2(a[2], a[3]); w.z = pk2(b[0], b[1]); w.w = pk2(b[2], b[3]); return w; }
__device__ __forceinline__ void unpack8bf(u32x4 w, f32x4& a, f32x4& b) { a = (f32x4){bflo(w.x), bfhi(w.x), bflo(w.y), bfhi(w.y)}; b = (f32x4){bflo(w.z), bfhi(w.z), bflo(w.w), bfhi(w.w)}; }
__device__ __forceinline__ f32x4 sig4(f32x4 v) { return (f32x4){sigmoidf_(v[0]), sigmoidf_(v[1]), sigmoidf_(v[2]), sigmoidf_(v[3])}; }

#define EPI_ROW(s) (row0 + ((s) >> 2) * 128 + ((s) & 3) * 16)
struct Epi1 {
    bf16* Q; bf16* Kb; bf16* Vb; bf16* U; bf16* GA; bf16* GB; const float* SA; const float* SW; const float* qg; const float* kg; PG8_LAS float* X  ;
    __device__ __forceinline__ void operator()(const Acc& acc, const pg8::Unit& u, int wr, int wc, int fr, int fq) const {
        const int pn = u.pn, row0 = u.pm * 256 + wr * 64 + fr, cw = wc * 32 + 8 * fq;
        const int b = (u.pm * 256) >> 12, t0 = (row0 & 4095);
        f32x4 swv[2][2]; float sav[8];
#pragma unroll
        for (int bj = 0; bj < 2; ++bj) { swv[bj][0] = *(const f32x4*)(SW + pn * 256 + bj * 128 + cw); swv[bj][1] = *(const f32x4*)(SW + pn * 256 + bj * 128 + cw + 4); }
#pragma unroll
        for (int s = 0; s < 8; ++s) sav[s] = SA[EPI_ROW(s)];
        if (pn < 16) {
            const float* gg = pn < 8 ? qg : kg;
            const f32x4 g0 = *(const f32x4*)(gg + cw), g1 = *(const f32x4*)(gg + cw + 4);
            const int ln = fr + 16 * fq, ad16 = (ln ^ 16) << 2, ad32 = (ln ^ 32) << 2;
            float ssv[16];
#pragma unroll
            for (int s = 0; s < 8; ++s) { const int ai = s >> 2, m = s & 3;
#pragma unroll
                for (int bj = 0; bj < 2; ++bj) {
                    const f32x4 v0 = deq4v(acc[ai][bj][m][0], swv[bj][0], sav[s]), v1 = deq4v(acc[ai][bj][m][1], swv[bj][1], sav[s]);
                    ssv[2 * s + bj] = (v0[0] * v0[0] + v0[1] * v0[1]) + (v0[2] * v0[2] + v0[3] * v0[3]) + (v1[0] * v1[0] + v1[1] * v1[1]) + (v1[2] * v1[2] + v1[3] * v1[3]); } }
#pragma unroll
            for (int i = 0; i < 16; ++i) ssv[i] += __builtin_bit_cast(float, __builtin_amdgcn_ds_bpermute(ad16, __builtin_bit_cast(int, ssv[i])));
#pragma unroll
            for (int i = 0; i < 16; ++i) ssv[i] += __builtin_bit_cast(float, __builtin_amdgcn_ds_bpermute(ad32, __builtin_bit_cast(int, ssv[i])));
            if (fq == 0) {
#pragma unroll
                for (int s = 0; s < 8; ++s) { const int rt = (s >> 2) * 128 + wr * 64 + (s & 3) * 16 + fr; X[(rt * 2) * 4 + wc] = ssv[2 * s]; X[(rt * 2 + 1) * 4 + wc] = ssv[2 * s + 1]; } }
            asm volatile("s_waitcnt lgkmcnt(0)" ::: "memory"); __builtin_amdgcn_s_barrier();
            bf16* base = pn < 8 ? Q + ((size_t)((b * NH + pn * 2) * SEQ + t0)) * HD + cw : Kb + ((size_t)((b * NH + (pn - 8) * 2) * SKV + KVPAD + t0)) * HD + cw;
            const size_t hstride = pn < 8 ? (size_t)SEQ * HD : (size_t)SKV * HD;
#pragma unroll
            for (int s = 0; s < 8; ++s) {
                const int ai = s >> 2, m = s & 3, rt = ai * 128 + wr * 64 + m * 16 + fr;
#pragma unroll
                for (int bj = 0; bj < 2; ++bj) {
                    const f32x4 v0 = deq4v(acc[ai][bj][m][0], swv[bj][0], sav[s]), v1 = deq4v(acc[ai][bj][m][1], swv[bj][1], sav[s]);
                    const f32x4 pp = *(const PG8_LAS f32x4*)(X + (rt * 2 + bj) * 4);
                    const float rs = 1.0f / sqrtf(((pp[0] + pp[1]) + (pp[2] + pp[3])) * (1.f / HD) + EPS);
                    *(u32x4*)(base + (size_t)(ai * 128 + m * 16) * HD + bj * hstride) = pack8bf(v0 * rs * g0, v1 * rs * g1);
                }
            }
            return;
        }
        bf16* base; size_t rstride, bstride;
        if (pn < 24) { base = Vb + ((size_t)((b * NH + (pn - 16) * 2) * SKV + KVPAD + t0)) * HD + cw; rstride = HD; bstride = (size_t)SKV * HD; }
        else if (pn < 32) { base = U + (size_t)row0 * SSMW + (pn - 24) * 256 + cw; rstride = SSMW; bstride = 128; }
        else { base = (pn < 48 ? GA : GB) + (size_t)row0 * DM + (pn & 15) * 256 + cw; rstride = DM; bstride = 128; }
        if (pn < 32) {
#pragma unroll
            for (int s = 0; s < 8; ++s) { const int ai = s >> 2, m = s & 3;
#pragma unroll
                for (int bj = 0; bj < 2; ++bj)
                    *(u32x4*)(base + (size_t)(ai * 128 + m * 16) * rstride + bj * bstride) = pack8bf(deq4v(acc[ai][bj][m][0], swv[bj][0], sav[s]), deq4v(acc[ai][bj][m][1], swv[bj][1], sav[s])); }
        } else {
#pragma unroll
            for (int s = 0; s < 8; ++s) { const int ai = s >> 2, m = s & 3;
#pragma unroll
                for (int bj = 0; bj < 2; ++bj)
                    *(u32x4*)(base + (size_t)(ai * 128 + m * 16) * rstride + bj * bstride) = pack8bf(sig4(deq4v(acc[ai][bj][m][0], swv[bj][0], sav[s])), sig4(deq4v(acc[ai][bj][m][1], swv[bj][1], sav[s]))); }
        }
    }
};
struct EpiGlu {
    const bf16* Z; bf16* AS;
    __device__ __forceinline__ void operator()(const Acc& acc, const pg8::Unit& u, int wr, int wc, int fr, int fq) const {
        const int row0 = u.pm * 256 + wr * 64 + fr, col0 = u.pn * 256 + wc * 32 + 8 * fq;
        u32x4 zq[8][2];
#define EPI_LD(s) do { _Pragma("unroll") for (int bj = 0; bj < 2; ++bj) zq[s][bj] = *(const u32x4*)(Z + (size_t)EPI_ROW(s) * SSMW + col0 + bj * 128); } while (0)
        EPI_LD(0); EPI_LD(1);
#pragma unroll
        for (int s = 0; s < 8; ++s) { const int ai = s >> 2, m = s & 3;
            if (s + 2 < 8) EPI_LD((s + 2) & 7);
#pragma unroll
            for (int bj = 0; bj < 2; ++bj) { f32x4 z0, z1; unpack8bf(zq[s][bj], z0, z1);
                *(u32x4*)(AS + (size_t)EPI_ROW(s) * DM + SSMW + col0 + bj * 128) = pack8bf(z0 * sig4(acc[ai][bj][m][0]), z1 * sig4(acc[ai][bj][m][1])); } }
#undef EPI_LD
    }
};
struct EpiBrA {
    const bf16* GA; bf16* T; const float* SA; const float* SW;
    __device__ __forceinline__ void operator()(const Acc& acc, const pg8::Unit& u, int wr, int wc, int fr, int fq) const {
        const int row0 = u.pm * 256 + wr * 64 + fr, col0 = u.pn * 256 + wc * 32 + 8 * fq;
        f32x4 swv[2][2]; float sav[8]; u32x4 gq[8][2];
#pragma unroll
        for (int bj = 0; bj < 2; ++bj) { swv[bj][0] = *(const f32x4*)(SW + col0 + bj * 128); swv[bj][1] = *(const f32x4*)(SW + col0 + bj * 128 + 4); }
#pragma unroll
        for (int s = 0; s < 8; ++s) sav[s] = SA[EPI_ROW(s)];
#define EPI_LD(s) do { _Pragma("unroll") for (int bj = 0; bj < 2; ++bj) gq[s][bj] = *(const u32x4*)(GA + (size_t)EPI_ROW(s) * DM + col0 + bj * 128); } while (0)
        EPI_LD(0); EPI_LD(1);
#pragma unroll
        for (int s = 0; s < 8; ++s) { const int ai = s >> 2, m = s & 3;
            if (s + 2 < 8) EPI_LD((s + 2) & 7);
#pragma unroll
            for (int bj = 0; bj < 2; ++bj) { f32x4 g0, g1; unpack8bf(gq[s][bj], g0, g1);
                *(u32x4*)(T + (size_t)EPI_ROW(s) * DM + col0 + bj * 128) = pack8bf(g0 * deq4v(acc[ai][bj][m][0], swv[bj][0], sav[s]), g1 * deq4v(acc[ai][bj][m][1], swv[bj][1], sav[s])); } }
#undef EPI_LD
    }
};
struct EpiBrB {
    const bf16* GB; const bf16* T; bf16* MIX; const float* SA; const float* SW;
    __device__ __forceinline__ void operator()(const Acc& acc, const pg8::Unit& u, int wr, int wc, int fr, int fq) const {
        const int row0 = u.pm * 256 + wr * 64 + fr, col0 = u.pn * 256 + wc * 32 + 8 * fq;
        f32x4 swv[2][2]; float sav[8]; u32x4 gq[8][2], tq[8][2];
#pragma unroll
        for (int bj = 0; bj < 2; ++bj) { swv[bj][0] = *(const f32x4*)(SW + col0 + bj * 128); swv[bj][1] = *(const f32x4*)(SW + col0 + bj * 128 + 4); }
#pragma unroll
        for (int s = 0; s < 8; ++s) sav[s] = SA[EPI_ROW(s)];
#define EPI_LD(s) do { _Pragma("unroll") for (int bj = 0; bj < 2; ++bj) { const size_t o_ = (size_t)EPI_ROW(s) * DM + col0 + bj * 128; gq[s][bj] = *(const u32x4*)(GB + o_); tq[s][bj] = *(const u32x4*)(T + o_); } } while (0)
        EPI_LD(0);
#pragma unroll
        for (int s = 0; s < 8; ++s) { const int ai = s >> 2, m = s & 3;
            if (s + 1 < 8) EPI_LD((s + 1) & 7);
#pragma unroll
            for (int bj = 0; bj < 2; ++bj) { f32x4 g0, g1, t0, t1; unpack8bf(gq[s][bj], g0, g1); unpack8bf(tq[s][bj], t0, t1);
                *(u32x4*)(MIX + (size_t)EPI_ROW(s) * DM + col0 + bj * 128) = pack8bf(t0 + g0 * deq4v(acc[ai][bj][m][0], swv[bj][0], sav[s]), t1 + g1 * deq4v(acc[ai][bj][m][1], swv[bj][1], sav[s])); } }
#undef EPI_LD
    }
};
struct EpiOut {
    static constexpr int NS = 16;
    const float* X; const float* SA; const float* SW; bf16* H2B; float* PSS; PG8_LAS float* XL  ;
    __device__ __forceinline__ void operator()(const Acc& acc, const pg8::Unit& u, int wr, int wc, int fr, int fq) const {
        const int row0 = u.pm * 256 + wr * 64 + fr, col0 = u.pn * 256 + wc * 32 + 8 * fq;
        f32x4 swv[2][2]; float sav[8]; f32x4 xq[8][2][2];
#pragma unroll
        for (int bj = 0; bj < 2; ++bj) { swv[bj][0] = *(const f32x4*)(SW + col0 + bj * 128); swv[bj][1] = *(const f32x4*)(SW + col0 + bj * 128 + 4); }
#pragma unroll
        for (int s = 0; s < 8; ++s) sav[s] = SA[EPI_ROW(s)];
        const int ln = fr + 16 * fq, ad16 = (ln ^ 16) << 2, ad32 = (ln ^ 32) << 2;
#define EPI_LD(s) do { _Pragma("unroll") for (int bj = 0; bj < 2; ++bj) { const size_t o_ = (size_t)EPI_ROW(s) * DM + col0 + bj * 128; xq[s][bj][0] = *(const f32x4*)(X + o_); xq[s][bj][1] = *(const f32x4*)(X + o_ + 4); } } while (0)
        EPI_LD(0);
        float ssv[8];
#pragma unroll
        for (int s = 0; s < 8; ++s) { const int ai = s >> 2, m = s & 3, rt = ai * 128 + wr * 64 + m * 16 + fr;
            if (s + 1 < 8) EPI_LD((s + 1) & 7);
            float ss = 0.f;
#pragma unroll
            for (int bj = 0; bj < 2; ++bj) { const size_t o = (size_t)EPI_ROW(s) * DM + col0 + bj * 128;
                const f32x4 h0 = xq[s][bj][0] + deq4v(acc[ai][bj][m][0], swv[bj][0], sav[s]), h1 = xq[s][bj][1] + deq4v(acc[ai][bj][m][1], swv[bj][1], sav[s]);
                *(u32x4*)(H2B + o) = pack8bf(h0, h1);
                ss += (h0[0] * h0[0] + h0[1] * h0[1]) + (h0[2] * h0[2] + h0[3] * h0[3]) + (h1[0] * h1[0] + h1[1] * h1[1]) + (h1[2] * h1[2] + h1[3] * h1[3]); }
            ssv[s] = ss; }
#undef EPI_LD
#pragma unroll
        for (int s = 0; s < 8; ++s) ssv[s] += __builtin_bit_cast(float, __builtin_amdgcn_ds_bpermute(ad16, __builtin_bit_cast(int, ssv[s])));
#pragma unroll
        for (int s = 0; s < 8; ++s) ssv[s] += __builtin_bit_cast(float, __builtin_amdgcn_ds_bpermute(ad32, __builtin_bit_cast(int, ssv[s])));
        if (fq == 0) {
#pragma unroll
            for (int s = 0; s < 8; ++s) XL[((s >> 2) * 128 + wr * 64 + (s & 3) * 16 + fr) * 4 + wc] = ssv[s]; }
        asm volatile("s_waitcnt lgkmcnt(0)" ::: "memory"); __builtin_amdgcn_s_barrier();
        const int tid = (wr * 4 + wc) * 64 + ln;
        if (tid < 256) { const f32x4 pp = *(const PG8_LAS f32x4*)(XL + tid * 4); PSS[(size_t)(u.pm * 256 + tid) * 16 + u.pn] = (pp[0] + pp[1]) + (pp[2] + pp[3]); }
    }
};
struct EpiQP {
    static constexpr int NS = 32;
    float* QP; const float* PSS;
    __device__ __forceinline__ void operator()(const Acc& acc, const pg8::Unit& u, int wr, int wc, int fr, int fq) const {
        const int row0 = u.pm * 256 + wr * 64 + fr, col0 = u.pn * 256 + wc * 32 + 8 * fq;
        float rs[8];
#pragma unroll
        for (int s = 0; s < 8; ++s) { const f32x4* p = (const f32x4*)(PSS + (size_t)EPI_ROW(s) * 16); const f32x4 a = (p[0] + p[1]) + (p[2] + p[3]);
            rs[s] = 1.0f / sqrtf(((a[0] + a[1]) + (a[2] + a[3])) * (1.f / DM) + EPS); }
#pragma unroll
        for (int s = 0; s < 8; ++s) { const int ai = s >> 2, m = s & 3;
#pragma unroll
            for (int bj = 0; bj < 2; ++bj) { float* d = QP + (size_t)EPI_ROW(s) * PEER_QW + col0 + bj * 128;
                *(f32x4*)d = acc[ai][bj][m][0] * rs[s]; *(f32x4*)(d + 4) = acc[ai][bj][m][1] * rs[s]; } }
    }
};
struct Ptrs {
    const float *x, *meta, *norm1_g, *w_in, *b_forget, *q_norm_g, *k_norm_g, *lam_re, *lam_im, *log_dt, *b_re, *b_im, *c_re, *c_im, *d_skip,
                *w_glu, *w_br_attn, *w_br_ssm, *w_out, *norm2_g, *w_query, *sub_keys, *expert_u, *expert_v;
    float* out; unsigned char* ws;
};

__device__ __forceinline__ void tr_tile(const float* W, int ldw, int col0, int ncols, int k0, bf16* WT, int ldk, int drow0, LAS float* scr, int lane) {
    const int c4 = 4 * (lane & 15), kq = lane >> 4;
    f32x4 vv[16];
#pragma unroll
    for (int i = 0; i < 16; ++i) { vv[i] = (f32x4){0.f, 0.f, 0.f, 0.f}; if (c4 < ncols) vv[i] = *(const f32x4*)(W + (size_t)(k0 + 4 * i + kq) * ldw + col0 + c4); }
#pragma unroll
    for (int i = 0; i < 16; ++i) { LAS float* s = scr + (4 * i + kq) * 65 + c4; s[0] = vv[i][0]; s[1] = vv[i][1]; s[2] = vv[i][2]; s[3] = vv[i][3]; }
    LDS_WAIT();
    const int c = lane & 7, nq = lane >> 3;
#pragma unroll 2
    for (int i = 0; i < 8; ++i) { const int n = 8 * i + nq; const LAS float* s = scr + (8 * c) * 65 + n;
        u32x4 o; o.x = pk2(s[0 * 65], s[1 * 65]); o.y = pk2(s[2 * 65], s[3 * 65]); o.z = pk2(s[4 * 65], s[5 * 65]); o.w = pk2(s[6 * 65], s[7 * 65]);
        if (n < ncols) *(u32x4*)(WT + (size_t)(drow0 + n) * ldk + k0 + 8 * c) = o; }
    LDS_WAIT();
}
__device__ __forceinline__ void absmax_tile(const float* W, int ldw, int k0, unsigned* cmax, int lane) {
    const float* wp = W + (size_t)k0 * ldw + 4 * lane; f32x4 m4 = (f32x4){0.f, 0.f, 0.f, 0.f};
#pragma unroll 8
    for (int k = 0; k < 64; ++k) { const f32x4 w = *(const f32x4*)(wp + (size_t)k * ldw); m4[0] = fmaxf(m4[0], fabsf(w[0])); m4[1] = fmaxf(m4[1], fabsf(w[1])); m4[2] = fmaxf(m4[2], fabsf(w[2])); m4[3] = fmaxf(m4[3], fabsf(w[3])); }
#pragma unroll
    for (int e = 0; e < 4; ++e) atomicMax(cmax + 4 * lane + e, __builtin_bit_cast(unsigned, m4[e]));
}
__device__ __forceinline__ void tr_tile_q8(const float* W, int ldw, int c0, int k0, unsigned char* W8, int ld8, int kofs, int n0, const unsigned* cmax, float* SW, LAS float* scr, int lane) {
    const int c4 = 4 * (lane & 15), kq = lane >> 4;
    const int c = lane & 7, nq = lane >> 3;
    f32x4 vv[16]; float cmv[8];
#pragma unroll
    for (int i = 0; i < 16; ++i) vv[i] = *(const f32x4*)(W + (size_t)(k0 + 4 * i + kq) * ldw + c0 + c4);
#pragma unroll
    for (int i = 0; i < 8; ++i) cmv[i] = __builtin_bit_cast(float, cmax[n0 + 8 * i + nq]);
#pragma unroll
    for (int i = 0; i < 16; ++i) { LAS float* s = scr + (4 * i + kq) * 65 + c4; s[0] = vv[i][0]; s[1] = vv[i][1]; s[2] = vv[i][2]; s[3] = vv[i][3]; }
    LDS_WAIT();
#pragma unroll 2
    for (int i = 0; i < 8; ++i) { const int n = 8 * i + nq; const LAS float* s = scr + (8 * c) * 65 + n;
        const float cm = cmv[i], inv = cm > 0.f ? 127.0f / cm : 0.f;
        unsigned q0 = 0u, q1 = 0u;
#pragma unroll
        for (int e = 0; e < 4; ++e) { q0 |= ((unsigned)(int)fminf(fmaxf(rintf(s[e * 65] * inv), -127.f), 127.f) & 0xffu) << (8 * e); q1 |= ((unsigned)(int)fminf(fmaxf(rintf(s[(4 + e) * 65] * inv), -127.f), 127.f) & 0xffu) << (8 * e); }
        *(u32x2*)(W8 + (size_t)(n0 + n) * ld8 + kofs + k0 + 8 * c) = (u32x2){q0, q1};
        if (k0 == 0 && c == 0) SW[n0 + n] = cm > 0.f ? cm * (1.0f / 127.0f) : 1.0f; }
    LDS_WAIT();
}
__device__ __forceinline__ void rowq8_load(u32x4 (&raw)[8], const bf16* src, int lane) {
#pragma unroll
    for (int j = 0; j < 8; ++j) raw[j] = *((const u32x4*)src + 64 * j + lane);
}
template <bool TWO> __device__ __forceinline__ void rowq8(const u32x4 (&raw)[8], unsigned char* dst, float* sc, int lane) {
    f32x4 a[8], b[8]; float m0 = 0.f, m1 = 0.f;
#pragma unroll
    for (int j = 0; j < 8; ++j) { unpack8bf(raw[j], a[j], b[j]);
        const float m = fmaxf(fmaxf(fmaxf(fabsf(a[j][0]), fabsf(a[j][1])), fmaxf(fabsf(a[j][2]), fabsf(a[j][3]))), fmaxf(fmaxf(fabsf(b[j][0]), fabsf(b[j][1])), fmaxf(fabsf(b[j][2]), fabsf(b[j][3]))));
        if (j < 4) m0 = fmaxf(m0, m); else m1 = fmaxf(m1, m); }
#pragma unroll
    for (int o = 1; o < 64; o <<= 1) { m0 = fmaxf(m0, __shfl_xor(m0, o)); m1 = fmaxf(m1, __shfl_xor(m1, o)); }
    if (!TWO) { m0 = fmaxf(m0, m1); m1 = m0; }
    const float s0 = m0 > 0.f ? m0 * (1.0f / 127.0f) : 1.0f, s1 = m1 > 0.f ? m1 * (1.0f / 127.0f) : 1.0f, i0 = 1.0f / s0, i1 = 1.0f / s1;
#pragma unroll
    for (int j = 0; j < 8; ++j) { const float inv = j < 4 ? i0 : i1; unsigned q0 = 0u, q1 = 0u;
#pragma unroll
        for (int e = 0; e < 4; ++e) { q0 |= ((unsigned)(int)fminf(fmaxf(rintf(a[j][e] * inv), -127.f), 127.f) & 0xffu) << (8 * e); q1 |= ((unsigned)(int)fminf(fmaxf(rintf(b[j][e] * inv), -127.f), 127.f) & 0xffu) << (8 * e); }
        *((u32x2*)dst + 64 * j + lane) = (u32x2){q0, q1}; }
    if (lane == 0) { sc[0] = s0; if (TWO) sc[NTOK] = s1; }
}
__device__ __forceinline__ void tr_tile_i8(const float* W, int n0, int k0, unsigned char* W8, const unsigned* cmax, float* SW, LAS float* scr, int lane) {
    const int c4 = 4 * (lane & 15), kq = lane >> 4;
    const int c = lane & 7, nq = lane >> 3;
    f32x4 vv[16]; float cmv[8];
#pragma unroll
    for (int i = 0; i < 16; ++i) vv[i] = *(const f32x4*)(W + (size_t)(k0 + 4 * i + kq) * NCOLS_SRC + n0 + (n0 >= 6144 ? 16 : 0) + c4);
#pragma unroll
    for (int i = 0; i < 8; ++i) cmv[i] = __builtin_bit_cast(float, cmax[n0 + 8 * i + nq]);
#pragma unroll
    for (int i = 0; i < 16; ++i) { LAS float* s = scr + (4 * i + kq) * 65 + c4; s[0] = vv[i][0]; s[1] = vv[i][1]; s[2] = vv[i][2]; s[3] = vv[i][3]; }
    LDS_WAIT();
#pragma unroll 2
    for (int i = 0; i < 8; ++i) { const int n = 8 * i + nq; const LAS float* s = scr + (8 * c) * 65 + n;
        const float cm = cmv[i], inv = cm > 0.f ? 127.0f / cm : 0.f;
        unsigned q0 = 0u, q1 = 0u;
#pragma unroll
        for (int e = 0; e < 4; ++e) { q0 |= ((unsigned)(int)fminf(fmaxf(rintf(s[e * 65] * inv), -127.f), 127.f) & 0xffu) << (8 * e); q1 |= ((unsigned)(int)fminf(fmaxf(rintf(s[(4 + e) * 65] * inv), -127.f), 127.f) & 0xffu) << (8 * e); }
        *(u32x2*)(W8 + (size_t)(n0 + n) * DM + k0 + 8 * c) = (u32x2){q0, q1};
        if (k0 == 0 && c == 0) SW[n0 + n] = cm > 0.f ? cm * (1.0f / 127.0f) : 1.0f; }
    LDS_WAIT();
}
__device__ __forceinline__ void split8(f32x4 x0, f32x4 x1, bf16x8& hi, bf16x8& lo) {
    const u32x4 h = pack8bf(x0, x1); f32x4 h0, h1; unpack8bf(h, h0, h1);
    hi = __builtin_bit_cast(bf16x8, h); lo = __builtin_bit_cast(bf16x8, pack8bf(x0 - h0, x1 - h1));
}
__device__ __forceinline__ void wq_fold_task(const Ptrs& P, int task, int lane) {
    const int hc = task >> 8, j0 = (task & 255) * 16, c = hc & 1, r = lane & 15, q = lane >> 4;
    bf16x8 ah[4], al[4];
    const float* wrow = P.w_query + (size_t)(j0 + r) * PEER_QW + hc * 128 + 8 * q; const float gj = P.norm2_g[j0 + r];
#pragma unroll
    for (int kb = 0; kb < 4; ++kb) split8(*(const f32x4*)(wrow + 32 * kb) * gj, *(const f32x4*)(wrow + 32 * kb + 4) * gj, ah[kb], al[kb]);
    bf16* out = (bf16*)(P.ws + WS_WQ) + (size_t)(hc * 128 + r) * DM + j0 + 4 * q;
    u32x2 ov[8];
#pragma unroll
    for (int nt = 0; nt < 8; ++nt) {
        const float* krow = P.sub_keys + (size_t)(c * 128 + nt * 16 + r) * 128 + 8 * q;
        f32x4 acc = (f32x4){0.f, 0.f, 0.f, 0.f};
#pragma unroll
        for (int kb = 0; kb < 4; ++kb) { bf16x8 bh, bl; split8(*(const f32x4*)(krow + 32 * kb), *(const f32x4*)(krow + 32 * kb + 4), bh, bl);
            acc = __builtin_amdgcn_mfma_f32_16x16x32_bf16(al[kb], bh, acc, 0, 0, 0); acc = __builtin_amdgcn_mfma_f32_16x16x32_bf16(ah[kb], bl, acc, 0, 0, 0);
            acc = __builtin_amdgcn_mfma_f32_16x16x32_bf16(ah[kb], bh, acc, 0, 0, 0); }
        ov[nt] = (u32x2){pk2(acc[0], acc[1]), pk2(acc[2], acc[3])};
    }
#pragma unroll
    for (int nt = 0; nt < 8; ++nt) *(u32x2*)(out + (size_t)(nt * 16) * DM) = ov[nt];
}
__device__ __forceinline__ void p0_prologue(const Ptrs& P, LAS unsigned char* lds, int gw, int NGW, int wave, int lane) {
    LAS float* scr = (LAS float*)(lds + wave * 16640);
    unsigned char* ws = P.ws;
    bf16* WT1 = (bf16*)(ws + WS_WT1); bf16* WGLU = (bf16*)(ws + WS_WGLU); bf16* WAB = (bf16*)(ws + WS_WAB); bf16* WOUT = (bf16*)(ws + WS_WOUT);
    constexpr int I0 = 64 * 64, I1 = 64, I2 = 64 * 32, I3 = 32 * 32;
    constexpr int NITEMS = I0 + I1 + I2 + I3;
    for (int it = gw; it < NITEMS; it += NGW) {
        int r = it;
        if (r < I0) { tr_tile(P.w_in, NCOLS_SRC, 2048 + (r % 64) * 64, 64, (r / 64) * 64, WT1, DM, C_K + (r % 64) * 64, scr, lane); continue; } r -= I0;
        if (r < I1) { tr_tile(P.w_in, NCOLS_SRC, 6144, 16, r * 64, WT1, DM, C_F, scr, lane); continue; } r -= I1;
        if (r < I2) { tr_tile(P.w_in, NCOLS_SRC, 6160 + (r % 32) * 64, 64, (r / 32) * 64, WT1, DM, C_U + (r % 32) * 64, scr, lane); continue; } r -= I2;
        tr_tile(P.w_glu, SSMW, (r % 32) * 64, 64, (r / 32) * 64, WGLU, SSMW, (r % 32) * 64, scr, lane);
    }
    for (int task = gw; task < 16 * 256; task += NGW) wq_fold_task(P, task, lane);
}
__device__ __forceinline__ void rms_row_load(f32x4 (&v)[16], const float* xrow, int lane) {
    const f32x4* xr = (const f32x4*)xrow + lane;
#pragma unroll
    for (int j = 0; j < 16; ++j) v[j] = xr[64 * j];
}
__device__ __forceinline__ void rms_row_proc(f32x4 (&v)[16], const f32x4 (&gv)[16], bf16* orow, int lane, unsigned char* orow8 = nullptr, float* sa_out = nullptr) {
    float s = 0.f;
#pragma unroll
    for (int j = 0; j < 16; ++j) s += (v[j][0] * v[j][0] + v[j][1] * v[j][1]) + (v[j][2] * v[j][2] + v[j][3] * v[j][3]);
    const float rs = 1.0f / sqrtf(wave_sum(s) * (1.f / DM) + EPS);
    u32x2* o8 = (u32x2*)orow + lane;
    float am = 0.f;
#pragma unroll
    for (int j = 0; j < 16; ++j) { const f32x4 gg = gv[j]; v[j] = v[j] * rs * gg; u32x2 w; w.x = pk2(v[j][0], v[j][1]); w.y = pk2(v[j][2], v[j][3]); o8[64 * j] = w;
        am = fmaxf(am, fmaxf(fmaxf(fabsf(v[j][0]), fabsf(v[j][1])), fmaxf(fabsf(v[j][2]), fabsf(v[j][3])))); }
    if (orow8) {
#pragma unroll
        for (int o = 1; o < 64; o <<= 1) am = fmaxf(am, __shfl_xor(am, o));
        const float sa = am > 0.f ? am * (1.0f / 127.0f) : 1.0f, inv = 1.0f / sa;
#pragma unroll
        for (int j = 0; j < 16; ++j) { unsigned q = 0u;
#pragma unroll
            for (int e = 0; e < 4; ++e) q |= ((unsigned)(int)fminf(fmaxf(rintf(v[j][e] * inv), -127.f), 127.f) & 0xffu) << (8 * e);
            ((unsigned*)orow8)[lane + 64 * j] = q; }
        if (lane == 0) *sa_out = sa;
    }
}

__device__ __forceinline__ f32x4 skinny_tile(const bf16* A, const bf16* Bt, int lane) {
    const bf16* ap = A + (size_t)(lane & 15) * DM + 8 * (lane >> 4); const bf16* bp = Bt + (size_t)(lane & 15) * DM + 8 * (lane >> 4);
    f32x4 acc = (f32x4){0.f, 0.f, 0.f, 0.f};
    for (int k0 = 0; k0 < DM; k0 += 256) {
        bf16x8 a[8], b[8];
#pragma unroll
        for (int i = 0; i < 8; ++i) { a[i] = *(const bf16x8*)(ap + k0 + 32 * i); b[i] = *(const bf16x8*)(bp + k0 + 32 * i); }
#pragma unroll
        for (int i = 0; i < 8; ++i) acc = __builtin_amdgcn_mfma_f32_16x16x32_bf16(a[i], b[i], acc, 0, 0, 0);
    }
    return acc;
}
__device__ __forceinline__ float log_sigmoid_(float x) { const float e = __expf(-fabsf(x)); return fminf(x, 0.f) - __logf(1.f + e); }
__device__ __forceinline__ void p1_prelude(const Ptrs& P, int gw, int NGW, int lane) {
    unsigned char* ws = P.ws;
    const bf16* HN = (const bf16*)(ws + WS_HN); const bf16* WT1 = (const bf16*)(ws + WS_WT1);
    float* LOGF = (float*)(ws + WS_LOGF); bf16* Kb = (bf16*)(ws + WS_K); bf16* Vb = (bf16*)(ws + WS_V); bf16* UM = (bf16*)(ws + WS_UMETA);
    constexpr int NF = NROWS / 16  , NMT = (3 * 2048) / 16  ;
    for (int it = gw; it < NF + NMT; it += NGW) {
        if (it < NF) {
            const f32x4 acc = skinny_tile(HN + (size_t)it * 16 * DM, WT1 + (size_t)C_F * DM, lane);
            const int h = lane & 15; const float bf = P.b_forget[h];
#pragma unroll
            for (int j = 0; j < 4; ++j) LOGF[(size_t)(it * 16 + 4 * (lane >> 4) + j) * 16 + h] = log_sigmoid_(acc[j] + bf);
        } else {
            const int ct = it - NF, cc = C_K + 16 * ct + (lane & 15);
            const f32x4 acc = skinny_tile(HN + (size_t)NTOK * DM, WT1 + (size_t)(C_K + 16 * ct) * DM, lane);
#pragma unroll
            for (int j = 0; j < 4; ++j) { const int mr = 4 * (lane >> 4) + j;
                if (cc < C_U) { bf16* dst = (cc < C_V) ? Kb : Vb; const int c2 = (cc < C_V) ? cc - C_K : cc - C_V, h = c2 >> 7, d = c2 & 127; const bf16 v = (bf16)f2bf(acc[j]);
#pragma unroll
                    for (int b = 0; b < NB; ++b) dst[((size_t)((b * NH + h) * SKV + (KVPAD - NMETA) + mr)) * HD + d] = v; }
                else UM[mr * SSMW + (cc - C_U)] = (bf16)f2bf(acc[j]); }
        }
    }
}

__device__ __forceinline__ void p2_cumsum(const Ptrs& P, int bh, int lane) {
    const float* LOGF = (const float*)(P.ws + WS_LOGF); float* BIAS = (float*)(P.ws + WS_BIAS) + (size_t)bh * SKV;
    const int b = bh >> 4, h = bh & 15, j0 = 65 * lane;
    float lf[65]; float tot = 0.f;
#pragma unroll
    for (int i = 0; i < 65; ++i) { const int pos = j0 + i - (KVPAD - NMETA);
        lf[i] = (pos < 0) ? 0.f : (pos < NMETA ? LOGF[(size_t)(NTOK + pos) * 16 + h] : LOGF[(size_t)(b * SEQ + pos - NMETA) * 16 + h]); }
#pragma unroll
    for (int i = 0; i < 65; ++i) tot += lf[i];
    float incl = tot;
#pragma unroll
    for (int o = 1; o < 64; o <<= 1) { const float n = __shfl_up(incl, o); if (lane >= o) incl += n; }
    float run = incl - tot;
#pragma unroll
    for (int i = 0; i < 65; ++i) { const int jp = j0 + i, pos = jp - (KVPAD - NMETA); run += lf[i];
        BIAS[jp] = (pos < 0) ? -__builtin_inff() : -run * 11.313708498984761f; }
}
__device__ __forceinline__ void qknorm4(bf16* rows  , const float* g, int lane) {
    bf16* p = rows + (size_t)(lane >> 4) * HD + 8 * (lane & 15);
    f32x4 a, b; unpack8bf(*(const u32x4*)p, a, b);
    float ss = (a[0] * a[0] + a[1] * a[1]) + (a[2] * a[2] + a[3] * a[3]) + (b[0] * b[0] + b[1] * b[1]) + (b[2] * b[2] + b[3] * b[3]);
    ss += __shfl_xor(ss, 1); ss += __shfl_xor(ss, 2); ss += __shfl_xor(ss, 4); ss += __shfl_xor(ss, 8);
    const float rs = 1.0f / sqrtf(ss * (1.f / HD) + EPS);
    const f32x4 g0 = *(const f32x4*)(g + 8 * (lane & 15)), g1 = *(const f32x4*)(g + 8 * (lane & 15) + 4);
    *(u32x4*)p = pack8bf(a * rs * g0, b * rs * g1);
}
__device__ __forceinline__ void p2_qknorm_zero(const Ptrs& P, int gw, int NGW, int lane) {
    bf16* Q = (bf16*)(P.ws + WS_Q); bf16* Kb = (bf16*)(P.ws + WS_K); bf16* Vb = (bf16*)(P.ws + WS_V);
    for (int it = gw; it < 64 * (NMETA / 4); it += NGW) { const int bh = it / (NMETA / 4), gq = it % (NMETA / 4); qknorm4(Kb + ((size_t)bh * SKV + (KVPAD - NMETA) + 4 * gq) * HD, P.k_norm_g, lane); }
    for (int it = gw; it < 128; it += NGW) { bf16* base = ((it & 1) ? Vb : Kb) + (size_t)(it >> 1) * SKV * HD;
        for (int i = lane; i < (KVPAD - NMETA) * HD * 2 / 16; i += 64) ((u32x4*)base)[i] = (u32x4){0u, 0u, 0u, 0u}; }
}

__device__ __forceinline__ void sincos_(float x, float& s, float& c) {
    const float k = rintf(x * 0.6366197723675814f); const int q = (int)k;
    float r = fmaf(k, -1.5703125f, x); r = fmaf(k, -4.837512969970703125e-4f, r); r = fmaf(k, -7.54978995489188e-8f, r);
    const float z = r * r;
    const float sp = r + r * z * (-1.6666654611e-1f + z * (8.3321608736e-3f + z * (-1.9515295891e-4f)));
    const float cp = 1.0f - 0.5f * z + z * z * (4.166664568298827e-2f + z * (-1.388731625493765e-3f + z * 2.443315711809948e-5f));
    const int qq = q & 3;
    s = (qq == 0) ? sp : (qq == 1) ? cp : (qq == 2) ? -sp : -cp;
    c = (qq == 0) ? cp : (qq == 1) ? -sp : (qq == 2) ? -cp : sp;
}
__device__ __forceinline__ void s5_tables(const Ptrs& P, int g, int lane) {
    unsigned char* T = P.ws + WS_S5T; const int p = lane;
    const float dt = expf(P.log_dt[g]), lr = P.lam_re[g * NS + p], li = P.lam_im[g * NS + p];
    const float mag = expf(lr * dt); float sn, cs; sincos_(li * dt, sn, cs);
    const float ar = mag * cs, ai = mag * sn, nr = ar - 1.0f, den = lr * lr + li * li;
    const float fr = (nr * lr + ai * li) / den, fi = (ai * lr - nr * li) / den;
    *((f32x2*)(T + S5T_AT) + g * NS + p) = (f32x2){ar, ai};
    float bbr[GC], bbi[GC];
    { const f32x4* brp = (const f32x4*)(P.b_re + (size_t)(g * NS + p) * GC); const f32x4* bip = (const f32x4*)(P.b_im + (size_t)(g * NS + p) * GC);
#pragma unroll
      for (int q = 0; q < 4; ++q) { const f32x4 br = brp[q], bi = bip[q];
#pragma unroll
          for (int e = 0; e < 4; ++e) { bbr[4 * q + e] = fr * br[e] - fi * bi[e]; bbi[4 * q + e] = fr * bi[e] + fi * br[e]; } } }
    { u32x4* bf = (u32x4*)(T + S5T_BFR) + (size_t)(g * 8 + (p >> 3)) * 64; const int m0 = 2 * (p & 7);
      bf[m0]      = (u32x4){pk2(bbr[0], bbr[1]), pk2(bbr[2], bbr[3]), pk2(bbr[4], bbr[5]), pk2(bbr[6], bbr[7])};
      bf[m0 + 16] = (u32x4){pk2(bbr[8], bbr[9]), pk2(bbr[10], bbr[11]), pk2(bbr[12], bbr[13]), pk2(bbr[14], bbr[15])};
      bf[m0 + 1]  = (u32x4){pk2(bbi[0], bbi[1]), pk2(bbi[2], bbi[3]), pk2(bbi[4], bbi[5]), pk2(bbi[6], bbi[7])};
      bf[m0 + 17] = (u32x4){pk2(bbi[8], bbi[9]), pk2(bbi[10], bbi[11]), pk2(bbi[12], bbi[13]), pk2(bbi[14], bbi[15])};
      const u32x4 z = (u32x4){0u, 0u, 0u, 0u}; bf[m0 + 32] = z; bf[m0 + 33] = z; bf[m0 + 48] = z; bf[m0 + 49] = z; }
    { const int c = lane & 15, kq = lane >> 4;
#pragma unroll
      for (int ks = 0; ks < 4; ++ks) { const int p0 = 16 * ks + 4 * kq;
          const f32x4 cr = *(const f32x4*)(P.c_re + (size_t)(g * GC + c) * NS + p0), ci = *(const f32x4*)(P.c_im + (size_t)(g * GC + c) * NS + p0);
          *((u32x4*)(T + S5T_CFR) + (size_t)(g * 4 + ks) * 64 + lane) = (u32x4){pk2(cr[0], -ci[0]), pk2(cr[1], -ci[1]), pk2(cr[2], -ci[2]), pk2(cr[3], -ci[3])}; } }
}
template <bool FINAL>
__device__ __forceinline__ void s5_unit(const Ptrs& P, int b, int g, int ch, LAS float* xl, LAS unsigned* sl, int lane) {
    const bf16* U = (const bf16*)(P.ws + WS_U); const bf16* UM = (const bf16*)(P.ws + WS_UMETA); float* E = (float*)(P.ws + WS_S5E); bf16* Z = (bf16*)(P.ws + WS_Z);
    const unsigned char* T = P.ws + WS_S5T; const int p = lane, t16 = lane & 15, q4 = lane >> 4;
    const f32x2 aa = *((const f32x2*)(T + S5T_AT) + g * NS + p); const float ar = aa[0], ai = aa[1];
    bf16x8 bfr[8];
#pragma unroll
    for (int mb = 0; mb < 8; ++mb) bfr[mb] = *((const bf16x8*)(T + S5T_BFR) + (size_t)(g * 8 + mb) * 64 + lane);
    bf16x8 cfr[4]; float dsk = 0.f;
    if (FINAL) {
#pragma unroll
        for (int ks = 0; ks < 4; ++ks) cfr[ks] = *((const bf16x8*)(T + S5T_CFR) + (size_t)(g * 4 + ks) * 64 + lane);
        dsk = P.d_skip[g * GC + t16];
    }
    float sr = 0.f, si = 0.f;
#define S5_LDU(dst, UP, urow0) do { dst = (bf16x8){0, 0, 0, 0, 0, 0, 0, 0}; if (q4 < 2) dst = *(const bf16x8*)((UP) + (size_t)((urow0) + t16) * SSMW + g * GC + 8 * q4); } while (0)
#define S5_LDS(dst, UP, urow0) do { _Pragma("unroll") for (int j = 0; j < 4; ++j) dst[j] = (UP)[(size_t)((urow0) + 4 * q4 + j) * SSMW + g * GC + t16]; } while (0)
#define S5_BLOCK(ub_, us_, urow0, OUT) do { \
        _Pragma("unroll") for (int mb = 0; mb < 8; ++mb) { const f32x4 d_ = __builtin_amdgcn_mfma_f32_16x16x32_bf16(bfr[mb], ub_, (f32x4){0.f, 0.f, 0.f, 0.f}, 0, 0, 0); \
            *(LAS f32x4*)(xl + t16 * 132 + 16 * mb + 4 * q4) = d_; } \
        LDS_WAIT(); \
        f32x2 xv_[16]; unsigned pv_[16];        \
        _Pragma("unroll") for (int tt = 0; tt < 16; ++tt) xv_[tt] = *(const LAS f32x2*)(xl + tt * 132 + 2 * p); \
        _Pragma("unroll") for (int tt = 0; tt < 16; ++tt) { \
            const float nsr = fmaf(ar, sr, fmaf(-ai, si, xv_[tt][0])), nsi = fmaf(ar, si, fmaf(ai, sr, xv_[tt][1])); sr = nsr; si = nsi; \
            if (OUT) pv_[tt] = pk2(sr, si); } \
        if (OUT) { _Pragma("unroll") for (int tt = 0; tt < 16; ++tt) sl[tt * 68 + p] = pv_[tt]; \
            LDS_WAIT(); \
            f32x4 y_ = (f32x4){0.f, 0.f, 0.f, 0.f}; \
            _Pragma("unroll") for (int ks = 0; ks < 4; ++ks) { const bf16x8 af_ = *(const LAS bf16x8*)(sl + t16 * 68 + 16 * ks + 4 * q4); y_ = __builtin_amdgcn_mfma_f32_16x16x32_bf16(af_, cfr[ks], y_, 0, 0, 0); } \
            _Pragma("unroll") for (int j = 0; j < 4; ++j) { const size_t row_ = (size_t)((urow0) + 4 * q4 + j); const float u_ = __builtin_bit_cast(float, (unsigned)us_[j] << 16); \
                Z[row_ * SSMW + g * GC + t16] = (bf16)f2bf(gelu_tanh(fmaf(dsk, u_, y_[j]))); } } \
        LDS_WAIT(); } while (0)
    bf16x8 ubc, ubn; bf16 usc[4] = {0, 0, 0, 0}, usn[4] = {0, 0, 0, 0};
    if (ch == 0) { S5_LDU(ubc, UM, 0); S5_BLOCK(ubc, usc, 0, false); }
    else if (FINAL) {
        float pr = ar, pi = ai;
#pragma unroll
        for (int q = 0; q < 9; ++q) { const float t = pr * pr - pi * pi; pi = 2.0f * pr * pi; pr = t; }
        f32x2 ev[NCH - 1];
#pragma unroll
        for (int c = 0; c < NCH - 1; ++c) { ev[c] = (f32x2){0.f, 0.f}; if (c < ch) ev[c] = *(const f32x2*)(E + ((size_t)((b * NG + g) * NCH + c) * NS + p) * 2); }
#pragma unroll
        for (int c = 0; c < NCH - 1; ++c) if (c < ch) { const float t = pr * sr - pi * si + ev[c][0]; si = pr * si + pi * sr + ev[c][1]; sr = t; }
    }
    const int row00 = b * SEQ + ch * LCH;
    S5_LDU(ubn, U, row00); if (FINAL) S5_LDS(usn, U, row00);
    for (int blk = 0; blk < LCH / 16; ++blk) {
        ubc = ubn;
#pragma unroll
        for (int j = 0; j < 4; ++j) usc[j] = usn[j];
        const int nrow = row00 + (blk + 1 < LCH / 16 ? blk + 1 : blk) * 16;
        S5_LDU(ubn, U, nrow); if (FINAL) S5_LDS(usn, U, nrow);
        S5_BLOCK(ubc, usc, row00 + blk * 16, FINAL); }
    if (!FINAL) *(f32x2*)(E + ((size_t)((b * NG + g) * NCH + ch) * NS + p) * 2) = (f32x2){sr, si};
#undef S5_BLOCK
#undef S5_LDU
#undef S5_LDS
}
namespace att {
using bf16 = __hip_bfloat16;
constexpr int D = 128, OSTR = 4096;
constexpr bool WSKIP = false; constexpr float THR = 8.f;
constexpr float SCALE = 0.08838834764831845f;
constexpr int NW = 8, QBLK = 32, KVBLK = 64, QB = NW * QBLK;
constexpr int SHM_V = KVBLK * D * 2, SHM_K = KVBLK * D * 2;
constexpr int LDS_BIAS = 2 * SHM_V + 2 * SHM_K + NW * 64 * 4;
constexpr int LDS_BYTES = LDS_BIAS + 2 * 64 * 4;

template <class A, class Bt> struct same_t { static constexpr bool v = false; };
template <class A> struct same_t<A, A> { static constexpr bool v = true; };

#define KSWZ(row, colB) ((row) * 256 + ((colB) ^ (((row) & 7) << 4)))
#define SBAR() __builtin_amdgcn_sched_barrier(0)
__device__ __forceinline__ int v_st(int k, int c) { const int kk = (k & ~0xC) | ((k & 4) << 1) | ((k & 8) >> 1); return ((kk >> 3) * 4 + (c >> 5)) * 512 + ((kk & 7) * 32 + (c & 31)) * 2; }
__device__ __forceinline__ int v_rd_base(int lane) { return ((lane & 3) << 3) | (((lane >> 2) & 3) << 6) | (((lane >> 4) & 1) << 5) | (((lane >> 5) & 1) << 8); }
constexpr int v_rd_off(int d0, int ks, int half) { return d0 * 512 + ks * 4096 + half * 2048; }
__device__ __forceinline__ int crow(int r, int hi) { return (r & 3) + 8 * (r >> 2) + 4 * hi; }
__device__ __forceinline__ unsigned cvtpk(float lo, float hi) {
    return pk2(lo, hi);
}
__device__ __forceinline__ bf16x8 pack8(f32x4 a, f32x4 b) {
    u32x4 w = {cvtpk(a[0], a[1]), cvtpk(a[2], a[3]), cvtpk(b[0], b[1]), cvtpk(b[2], b[3])};
    return *reinterpret_cast<bf16x8*>(&w);
}
template <class T> __device__ __forceinline__ bf16x8 load8(const T* p) {
    if constexpr (same_t<T, float>::v) { return pack8(*(const f32x4*)p, *(const f32x4*)(p + 4)); }
    else { return *reinterpret_cast<const bf16x8*>(p); }
}
__device__ __forceinline__ void mask_tile(f32x16& p0, f32x16& p1, int dq, unsigned W) {
    const float NEG = -__builtin_inff();
#pragma unroll
    for (int r = 0; r < 16; ++r) {
        const int c = (r & 3) + 8 * (r >> 2);
        if ((unsigned)(dq - c) >= W) p0[r] = NEG;
        if ((unsigned)(dq - c - 32) >= W) p1[r] = NEG;
    }
}
__device__ __forceinline__ void partialSM(f32x16& p0, f32x16& p1, float& m_reg, float& mn, float& alpha) {
    float pmax = p0[0]; for (int r = 1; r < 16; ++r) pmax = fmaxf(pmax, p0[r]); for (int r = 0; r < 16; ++r) pmax = fmaxf(pmax, p1[r]);
    { auto rr = __builtin_amdgcn_permlane32_swap(__float_as_uint(pmax), __float_as_uint(pmax), false, false);
      pmax = fmaxf(__uint_as_float(rr[0]), __uint_as_float(rr[1])); }
    constexpr float C2 = 1.4426950408889634f * SCALE;
    if (__builtin_expect(__all((pmax - m_reg) * SCALE <= THR), 1)) { mn = m_reg; alpha = 1.f; }
    else { mn = fmaxf(m_reg, pmax); alpha = __builtin_amdgcn_exp2f((m_reg - mn) * C2); m_reg = mn; }
    const float mnL = -mn * C2;
    for (int r = 0; r < 16; ++r) p0[r] = fmaf(p0[r], C2, mnL); for (int r = 0; r < 16; ++r) p1[r] = fmaf(p1[r], C2, mnL);
    for (int r = 0; r < 16; ++r) p0[r] = __builtin_amdgcn_exp2f(p0[r]);
}
__device__ __forceinline__ void finishSM(f32x16& p0, f32x16& p1, float alpha, float& l_reg, bf16x8& pa0, bf16x8& pa1, bf16x8& pa2, bf16x8& pa3) {
    for (int r = 0; r < 16; ++r) p1[r] = __builtin_amdgcn_exp2f(p1[r]);
    float ps = 0; for (int r = 0; r < 16; ++r) ps += p0[r]; for (int r = 0; r < 16; ++r) ps += p1[r];
    { auto rr = __builtin_amdgcn_permlane32_swap(__float_as_uint(ps), __float_as_uint(ps), false, false);
      ps = __uint_as_float(rr[0]) + __uint_as_float(rr[1]); }
    l_reg = l_reg * alpha + ps;
#define PK4(P, B_, OUT) do { unsigned a0 = cvtpk(P[B_+0], P[B_+1]), a1 = cvtpk(P[B_+2], P[B_+3]);                          \
        unsigned b0 = cvtpk(P[B_+4], P[B_+5]), b1 = cvtpk(P[B_+6], P[B_+7]);                                             \
        auto r0 = __builtin_amdgcn_permlane32_swap(a0, b0, false, false); auto r1 = __builtin_amdgcn_permlane32_swap(a1, b1, false, false); \
        u32x4 w = {r0[0], r1[0], r0[1], r1[1]}; OUT = *reinterpret_cast<bf16x8*>(&w); } while (0)
    PK4(p0, 0, pa0); PK4(p0, 8, pa1); PK4(p1, 0, pa2); PK4(p1, 8, pa3);
#undef PK4
}
template <int KB, bool SK>
__device__ __forceinline__ void qkt(f32x16& p0, f32x16& p1, const char* K_lds, int r32, int hi, const bf16x8* qr, bool act) {
    if (SK && !act) { const float NEG = -__builtin_inff();
#pragma unroll
        for (int r = 0; r < 16; ++r) { p0[r] = NEG; p1[r] = NEG; } return; }
    { const float* bl = (const float*)(K_lds + 2 * SHM_K + NW * 64 * 4) + KB * 64 + 4 * hi;
      const f32x4 b0 = *(const f32x4*)(bl), b1 = *(const f32x4*)(bl + 8), b2 = *(const f32x4*)(bl + 16), b3 = *(const f32x4*)(bl + 24);
      const f32x4 c0 = *(const f32x4*)(bl + 32), c1 = *(const f32x4*)(bl + 40), c2 = *(const f32x4*)(bl + 48), c3 = *(const f32x4*)(bl + 56);
      p0 = (f32x16){b0[0], b0[1], b0[2], b0[3], b1[0], b1[1], b1[2], b1[3], b2[0], b2[1], b2[2], b2[3], b3[0], b3[1], b3[2], b3[3]};
      p1 = (f32x16){c0[0], c0[1], c0[2], c0[3], c1[0], c1[1], c1[2], c1[3], c2[0], c2[1], c2[2], c2[3], c3[0], c3[1], c3[2], c3[3]}; }
    const char* kb[4];
#pragma unroll
    for (int dd = 0; dd < 4; ++dd) kb[dd] = K_lds + KB * SHM_K + KSWZ(r32, (dd * 16 + hi * 8) * 2);
#pragma unroll
    for (int d0 = 0; d0 < 8; ++d0) { const char* a = kb[d0 & 3] + (d0 >> 2) * 128;
        bf16x8 b0 = *reinterpret_cast<const bf16x8*>(a);
        bf16x8 b1 = *reinterpret_cast<const bf16x8*>(a + 32 * 256);
        p0 = __builtin_amdgcn_mfma_f32_32x32x16_bf16(b0, qr[d0], p0, 0, 0, 0);
        p1 = __builtin_amdgcn_mfma_f32_32x32x16_bf16(b1, qr[d0], p1, 0, 0, 0); }
}
template <int VB, bool SK>
__device__ __forceinline__ void pv_tile(f32x16* o, int vb0, bf16x8 pa0, bf16x8 pa1, bf16x8 pa2, bf16x8 pa3, bool act) {
    if (SK && !act) return;
#define TRRD(dst, off) asm volatile("ds_read_b64_tr_b16 %0, %1 offset:%2" : "=&v"(dst) : "v"(vb0), "i"(off) : "memory")
#define PV_D0(d0) do { s16x4 l0, l1, l2, l3, h0, h1, h2, h3; constexpr int b_ = VB * SHM_V + v_rd_off(d0, 0, 0);     \
        TRRD(l0, b_); TRRD(h0, b_ + 2048); TRRD(l1, b_ + 4096); TRRD(h1, b_ + 6144); TRRD(l2, b_ + 8192); TRRD(h2, b_ + 10240); TRRD(l3, b_ + 12288); TRRD(h3, b_ + 14336); \
        asm volatile("s_waitcnt lgkmcnt(0)" ::: "memory"); SBAR();                 \
        o[d0] = __builtin_amdgcn_mfma_f32_32x32x16_bf16(pa0, (bf16x8){l0[0], l0[1], l0[2], l0[3], h0[0], h0[1], h0[2], h0[3]}, o[d0], 0, 0, 0);   \
        o[d0] = __builtin_amdgcn_mfma_f32_32x32x16_bf16(pa1, (bf16x8){l1[0], l1[1], l1[2], l1[3], h1[0], h1[1], h1[2], h1[3]}, o[d0], 0, 0, 0);   \
        o[d0] = __builtin_amdgcn_mfma_f32_32x32x16_bf16(pa2, (bf16x8){l2[0], l2[1], l2[2], l2[3], h2[0], h2[1], h2[2], h2[3]}, o[d0], 0, 0, 0);   \
        o[d0] = __builtin_amdgcn_mfma_f32_32x32x16_bf16(pa3, (bf16x8){l3[0], l3[1], l3[2], l3[3], h3[0], h3[1], h3[2], h3[3]}, o[d0], 0, 0, 0); } while (0)
    PV_D0(0); PV_D0(1); PV_D0(2); PV_D0(3);
#undef PV_D0
#undef TRRD
}

template <class TIn, class TOut> struct BlockRef { const TIn* Q; const TIn* K; const TIn* V; TOut* O; const float* Bias; int P0; };
template <class TIn> struct Seam {
    bf16x8 qr[8];
    bf16x8 st_v0, st_v1, st_k0, st_k1; f32x4 sf0, sf1, sf2, sf3; float st_b;
    f32x4 tq[16];
};
__device__ __forceinline__ int swa_jlo(int P0, int W) { const int lowk = P0 - W + 1; return lowk > 0 ? lowk / KVBLK : 0; }
#define ROW(p, k0, rr) ((p) + (size_t)((k0) + (rr)) * D + sc)
#define VMW() asm volatile("s_waitcnt vmcnt(0)" ::: "memory")
#define VMWN(n) asm volatile("s_waitcnt vmcnt(%0)" :: "i"(n) : "memory")
#define SLOAD_H(Kp, Vp, k0) do { S.st_v0 = load8<TIn>(ROW(Vp, k0, sr)); S.st_v1 = load8<TIn>(ROW(Vp, k0, 32 + sr));              \
                         S.st_k0 = load8<TIn>(ROW(Kp, k0, sr)); S.st_k1 = load8<TIn>(ROW(Kp, k0, 32 + sr)); if (wid == 0) S.st_b = BiasP[(k0) + lane]; } while (0)
#define SWRITE_HK(bf) do { *(bf16x8*)(K_lds + (bf) * SHM_K + kws) = S.st_k0; *(bf16x8*)(K_lds + (bf) * SHM_K + kws + 32 * 256) = S.st_k1; \
                           if (wid == 0) ((float*)(K_lds + 2 * SHM_K + NW * 64 * 4))[(bf) * 64 + lane] = S.st_b; } while (0)
#define SWRITE_HV(bf) do { *(bf16x8*)(V_lds + (bf) * SHM_V + vst0) = S.st_v0; *(bf16x8*)(V_lds + (bf) * SHM_V + vst1) = S.st_v1; } while (0)
#define SWRITE_H(bf) do { SWRITE_HV(bf); SWRITE_HK(bf); } while (0)
#define SLOAD_F(p, k0) do { S.sf0 = *(const f32x4*)ROW(p, k0, sr); S.sf1 = *(const f32x4*)(ROW(p, k0, sr) + 4);                \
                            S.sf2 = *(const f32x4*)ROW(p, k0, 32 + sr); S.sf3 = *(const f32x4*)(ROW(p, k0, 32 + sr) + 4); } while (0)
#define SWRITE_KF(bf) do { *(bf16x8*)(K_lds + (bf) * SHM_K + kws) = pack8(S.sf0, S.sf1); *(bf16x8*)(K_lds + (bf) * SHM_K + kws + 32 * 256) = pack8(S.sf2, S.sf3); } while (0)
#define SWRITE_VF(bf) do { *(bf16x8*)(V_lds + (bf) * SHM_V + vst0) = pack8(S.sf0, S.sf1); *(bf16x8*)(V_lds + (bf) * SHM_V + vst1) = pack8(S.sf2, S.sf3); } while (0)
template <class TIn, class TOut>
__device__ __forceinline__ void causal_swa_prime(const BlockRef<TIn, TOut>& cur, int W, char* lds, Seam<TIn>& S) {
    constexpr bool F32 = same_t<TIn, float>::v;
    int tid_ = threadIdx.x; asm volatile("" : "+v"(tid_)); const int tid = tid_, wid = __builtin_amdgcn_readfirstlane(tid >> 6), lane = tid & 63, r32 = lane & 31, hi = lane >> 5;
    const int sr = tid >> 4, sc = (tid & 15) * 8, kws = KSWZ(sr, sc * 2); char* K_lds = lds + 2 * SHM_V;
    const int kb0 = swa_jlo(cur.P0, W) * KVBLK; const float* BiasP = cur.Bias;
    for (int d0 = 0; d0 < 8; ++d0) S.qr[d0] = load8<TIn>(cur.Q + (size_t)(wid * QBLK + r32) * D + d0 * 16 + hi * 8);
    if constexpr (F32) { SLOAD_F((const float*)cur.K, kb0); VMW(); SWRITE_KF(0); SBAR(); SLOAD_F((const float*)cur.V, kb0); }
    else { SLOAD_H(cur.K, cur.V, kb0); VMW(); SWRITE_HK(0); }
    __syncthreads();
}
template <class TIn, class TOut>
__device__ __forceinline__ void causal_swa_block(const BlockRef<TIn, TOut>& cur, const BlockRef<TIn, TOut>& nxt, int skv, int W, char* lds, Seam<TIn>& S) {
    constexpr bool F32 = same_t<TIn, float>::v;
    int tid_ = threadIdx.x; asm volatile("" : "+v"(tid_)); const int tid = tid_, wid = __builtin_amdgcn_readfirstlane(tid >> 6), lane = tid & 63, r32 = lane & 31, hi = lane >> 5;
    const int j_lo = swa_jlo(cur.P0, W);
    int j_hi = (cur.P0 + QB - 1) / KVBLK + 1; if (j_hi > skv / KVBLK) j_hi = skv / KVBLK;
    const int NT = j_hi - j_lo;
    const int kbn = swa_jlo(nxt.P0, W) * KVBLK;
    const int qlo = cur.P0 + wid * QBLK, qm = qlo + r32 - 4 * hi;
    char* V_lds = lds; char* K_lds = lds + 2 * SHM_V;
    float* ws = (float*)(lds + 2 * SHM_V + 2 * SHM_K) + wid * 64; float* li_l = ws, * al_l = ws + 32;
    float m_reg = -1e30f, l_reg = 0; f32x16 o[4] = {};
    const int sr = tid >> 4, sc = (tid & 15) * 8, vst0 = v_st(sr, sc), vst1 = v_st(32 + sr, sc), kws = KSWZ(sr, sc * 2);
    const int vb0 = (int)(uintptr_t)V_lds + v_rd_base(lane);
    const TIn* Kh = cur.K; const TIn* Vh = cur.V; const float* BiasP = cur.Bias;
#define RESC(a) do { if (__any((a) < 1.f)) { if (hi == 0) al_l[r32] = (a); asm volatile("s_waitcnt lgkmcnt(0)" ::: "memory");              \
                     for (int d_ = 0; d_ < 4; ++d_) for (int r = 0; r < 16; ++r) o[d_][r] *= al_l[crow(r, hi)]; } } while (0)
#define KBASE(t) ((j_lo + (t)) * KVBLK)
#define ACT(t) (KBASE(t) <= qlo + QBLK - 1 && KBASE(t) + KVBLK - 1 >= qlo - W + 1)
#define MASKT(P0_, P1_, t) do { const int kb_ = KBASE(t); if ((!SK || ACT(t)) && (kb_ + KVBLK - 1 > qlo || kb_ <= qlo + QBLK - 1 - W)) mask_tile(P0_, P1_, qm - kb_, (unsigned)W); } while (0)
    constexpr int NQL = F32 ? 16 : 8;
    constexpr bool SK = WSKIP && !F32;
#define SEAM_K0() do { VMWN(NQL); if constexpr (F32) { SWRITE_KF(0); SBAR(); SLOAD_F((const float*)nxt.V, kbn); } else { SWRITE_HK(0); } SBAR(); } while (0)
    f32x16 pA0, pA1, pB0, pB1; float mnA, mnB, alA, alB; bf16x8 pa0, pa1, pa2, pa3;
    if constexpr (F32) { VMW(); SWRITE_VF(0); SBAR(); } else { SWRITE_HV(0); SBAR(); }
    if (NT > 1) { if constexpr (F32) SLOAD_F((const float*)Kh, KBASE(1)); else SLOAD_H(Kh, Vh, KBASE(1)); }
    SBAR(); qkt<0, SK>(pA0, pA1, K_lds, r32, hi, S.qr, ACT(0));
    if constexpr (F32) { if (NT > 1) { VMW(); SWRITE_KF(1); SBAR(); SLOAD_F((const float*)Vh, KBASE(1)); } }
    MASKT(pA0, pA1, 0); partialSM(pA0, pA1, m_reg, mnA, alA);
    if (NT > 1) { VMW(); if constexpr (F32) { SWRITE_VF(1); SBAR(); if (NT > 2) SLOAD_F((const float*)Kh, KBASE(2)); } else SWRITE_H(1); }
    __syncthreads();
#define HALF_STEP(PX0, PX1, mnX, alX, PY0, PY1, alY, t, KB, VB, SB) do {                                                      \
        SBAR(); qkt<KB, SK>(PX0, PX1, K_lds, r32, hi, S.qr, ACT(t));                                             \
        finishSM(PY0, PY1, alY, l_reg, pa0, pa1, pa2, pa3); SBAR();                                                           \
        if ((t) + 1 < NT) { if constexpr (F32) { VMW(); SWRITE_KF(SB); SBAR(); SLOAD_F((const float*)Vh, KBASE((t) + 1)); }  \
                            else { SLOAD_H(Kh, Vh, KBASE((t) + 1)); } SBAR(); }                                               \
        pv_tile<VB, SK>(o, vb0, pa0, pa1, pa2, pa3, ACT((t) - 1)); MASKT(PX0, PX1, (t)); partialSM(PX0, PX1, m_reg, mnX, alX);                                        \
        __syncthreads();                                                                                                      \
        if ((t) + 1 < NT) { VMW(); if constexpr (F32) { SWRITE_VF(SB); SBAR(); if ((t) + 2 < NT) SLOAD_F((const float*)Kh, KBASE((t) + 2)); } \
                            else { SWRITE_H(SB); } }                                                                          \
        RESC(alX); __syncthreads(); } while (0)
    for (int t = 1; t + 1 < NT; t += 2) {
        HALF_STEP(pB0, pB1, mnB, alB, pA0, pA1, alA, t, 1, 0, 0);
        HALF_STEP(pA0, pA1, mnA, alA, pB0, pB1, alB, t + 1, 0, 1, 1);
    }
    const bool even = (NT & 1) == 0;
    if (even) { SBAR(); qkt<1, SK>(pB0, pB1, K_lds, r32, hi, S.qr, ACT(NT - 1)); SBAR(); }
#define QROW(e) (nxt.Q + (size_t)(wid * QBLK + r32) * D + ((e) >> 1) * 16 + hi * 8 + ((e) & 1) * 4)
    if constexpr (F32) { SLOAD_F((const float*)nxt.K, kbn); SBAR();
#pragma unroll
        for (int e = 0; e < 8; ++e) S.tq[e] = *(const f32x4*)QROW(e); }
    else { { const float* BiasP = nxt.Bias; SLOAD_H(nxt.K, nxt.V, kbn); } SBAR();
#pragma unroll
        for (int d0 = 0; d0 < 8; ++d0) S.qr[d0] = load8<TIn>(nxt.Q + (size_t)(wid * QBLK + r32) * D + d0 * 16 + hi * 8); }
    SBAR();
    finishSM(pA0, pA1, alA, l_reg, pa0, pa1, pa2, pa3); SBAR();
    if constexpr (F32) {
#pragma unroll
        for (int e = 8; e < 16; ++e) S.tq[e] = *(const f32x4*)QROW(e); SBAR(); }
#undef QROW
    pv_tile<0, SK>(o, vb0, pa0, pa1, pa2, pa3, ACT(even ? NT - 2 : NT - 1));
    if (even) { MASKT(pB0, pB1, NT - 1); partialSM(pB0, pB1, m_reg, mnB, alB); __syncthreads(); RESC(alB);
        finishSM(pB0, pB1, alB, l_reg, pa0, pa1, pa2, pa3); SBAR(); pv_tile<1, SK>(o, vb0, pa0, pa1, pa2, pa3, ACT(NT - 1)); }
    SBAR(); SEAM_K0();
    if (hi == 0) li_l[r32] = l_reg; asm volatile("s_waitcnt lgkmcnt(0)" ::: "memory");
    float rli[16];
#pragma unroll
    for (int r = 0; r < 16; ++r) rli[r] = __builtin_amdgcn_rcpf(li_l[crow(r, hi)]);
    TOut* Ow = cur.O + (size_t)(wid * QBLK) * OSTR;
#pragma unroll
    for (int r = 0; r < 16; ++r) { const int orow = crow(r, hi);
#pragma unroll
        for (int d0 = 0; d0 < 4; ++d0) { const float v = o[d0][r] * rli[r];
            if constexpr (same_t<TOut, float>::v) { Ow[(size_t)orow * OSTR + d0 * 32 + r32] = v; }
            else { const float vn = __builtin_bit_cast(float, __builtin_amdgcn_update_dpp(0, __builtin_bit_cast(int, v), 0xB1  , 0xf, 0xf, true));
                   if ((r32 & 1) == 0) *(unsigned*)(Ow + (size_t)orow * OSTR + d0 * 32 + r32) = cvtpk(v, vn); } } }
    if constexpr (F32) {
#pragma unroll
        for (int d0 = 0; d0 < 8; ++d0) S.qr[d0] = pack8(S.tq[2 * d0], S.tq[2 * d0 + 1]); }
    __syncthreads();
#undef RESC
#undef KBASE
#undef ACT
#undef MASKT
#undef SEAM_K0
#undef HALF_STEP
}
#undef ROW
#undef VMW
#undef VMWN
#undef SLOAD_H
#undef SWRITE_HK
#undef SWRITE_HV
#undef SWRITE_H
#undef SLOAD_F
#undef SWRITE_KF
#undef SWRITE_VF
}
__device__ __forceinline__ att::BlockRef<att::bf16, att::bf16> attn_ref(const Ptrs& P, int bh, int qb) {
    att::BlockRef<att::bf16, att::bf16> r; const int b = bh >> 4, h = bh & 15;
    r.Q = (const att::bf16*)(P.ws + WS_Q) + ((size_t)bh * SEQ + (size_t)qb * 256) * HD;
    r.K = (const att::bf16*)(P.ws + WS_K) + (size_t)bh * SKV * HD; r.V = (const att::bf16*)(P.ws + WS_V) + (size_t)bh * SKV * HD;
    r.O = (att::bf16*)(P.ws + WS_AS) + ((size_t)b * SEQ + (size_t)qb * 256) * DM + h * HD;
    r.Bias = (const float*)(P.ws + WS_BIAS) + (size_t)bh * SKV; r.P0 = KVPAD + qb * 256;
    return r;
}
__device__ __forceinline__ void attn_phase(const Ptrs& P, char* lds, int vcu, int G) {
    constexpr int NX = 8, TOTAL = NX * NB * NH, WBIG = 1 << 20;
    int L = vcu; if (L >= TOTAL) return;
    int pass = 0;
    att::BlockRef<att::bf16, att::bf16> cur = attn_ref(P, L >> 3, L & 7);
    att::Seam<att::bf16> S;
    att::causal_swa_prime<att::bf16, att::bf16>(cur, WBIG, lds, S);
    for (;;) {
        const bool more_pass = pass == 0, more_item = L + G < TOTAL, last = !more_pass && !more_item;
        int passn = pass + 1, Ln = L;
        if (!more_pass) { passn = 0; Ln = more_item ? L + G : L; }
        const int qbn = passn ? 15 - (Ln & 7) : (Ln & 7);
        const att::BlockRef<att::bf16, att::bf16> nxt = last ? cur : attn_ref(P, Ln >> 3, qbn);
        att::causal_swa_block<att::bf16, att::bf16>(cur, nxt, SKV, WBIG, lds, S);
        if (last) break;
        cur = nxt; pass = passn; L = Ln;
    }
}

__device__ __forceinline__ float dpp_xor1(float v) { return __builtin_bit_cast(float, __builtin_amdgcn_update_dpp(0, __builtin_bit_cast(int, v), 0xB1, 0xf, 0xf, true)); }
__device__ __forceinline__ float dpp_xor2(float v) { return __builtin_bit_cast(float, __builtin_amdgcn_update_dpp(0, __builtin_bit_cast(int, v), 0x4E, 0xf, 0xf, true)); }
__device__ __forceinline__ unsigned fkey(float f) { const unsigned u = __builtin_bit_cast(unsigned, f); return u ^ ((u >> 31) ? 0xFFFFFFFFu : 0x80000000u); }
template <int NV> __device__ __forceinline__ unsigned thr16(const unsigned (&k)[NV]) {
    unsigned prefix = 0u;
    for (int bit = 31; bit >= 0; --bit) {
        const unsigned cand = prefix | (1u << bit); int cnt = 0;
#pragma unroll
        for (int v = 0; v < NV; ++v) cnt += __popcll(__ballot(k[v] >= cand));
        if (cnt >= 16) prefix = cand;
        if (cnt == 16) break;
    }
    return prefix;
}
__device__ __forceinline__ float dot2bf(unsigned a, unsigned b, float acc) { asm volatile("v_dot2c_f32_bf16 %0, %1, %2" : "+v"(acc) : "v"(a), "v"(b)); return acc; }
__device__ __forceinline__ float dot8(u32x4 w, u32x4 x, float acc) {
    acc = dot2bf(w.x, x.x, acc); acc = dot2bf(w.y, x.y, acc); acc = dot2bf(w.z, x.z, acc); acc = dot2bf(w.w, x.w, acc);
    return acc;
}
__device__ __forceinline__ void peer_select(const Ptrs& P, int tok, LAS float* TV, LAS int* TI, LAS int* EX, LAS float* GT, int lane) {
    const float* QP = (const float*)(P.ws + WS_GA) + (size_t)tok * PEER_QW;
    const unsigned long long lt = (1ull << lane) - 1ull;
    for (int c = 0; c < 2; ++c) {
        float s0[PEER_H], s1[PEER_H];
#pragma unroll
        for (int h = 0; h < PEER_H; ++h) { s0[h] = QP[h * 256 + c * 128 + lane]; s1[h] = QP[h * 256 + c * 128 + 64 + lane]; }
#pragma unroll
        for (int h = 0; h < PEER_H; ++h) {
            const unsigned kk[2] = {fkey(s0[h]), fkey(s1[h])}; const unsigned T = thr16<2>(kk);
            const unsigned long long m0 = __ballot(kk[0] >= T), m1 = __ballot(kk[1] >= T);
            const int r0 = __popcll(m0 & lt), r1 = __popcll(m0) + __popcll(m1 & lt), row = h * 2 + c;
            if (kk[0] >= T && r0 < 16) { TV[row * 16 + r0] = s0[h]; TI[row * 16 + r0] = lane; }
            if (kk[1] >= T && r1 < 16) { TV[row * 16 + r1] = s1[h]; TI[row * 16 + r1] = lane + 64; }
        }
    }
    LDS_WAIT();
    for (int h = 0; h < PEER_H; ++h) {
        const int i = lane >> 2, jb = 4 * (lane & 3);
        const float a = TV[(h * 2) * 16 + i]; const f32x4 b4 = *(const LAS f32x4*)(TV + (h * 2 + 1) * 16 + jb);
        const float cd[4] = {a + b4[0], a + b4[1], a + b4[2], a + b4[3]};
        const unsigned kk[4] = {fkey(cd[0]), fkey(cd[1]), fkey(cd[2]), fkey(cd[3])}; const unsigned T = thr16<4>(kk);
        const int i1 = TI[(h * 2) * 16 + i]; int base = 0;
#pragma unroll
        for (int v = 0; v < 4; ++v) { const unsigned long long m = __ballot(kk[v] >= T); const int r = base + __popcll(m & lt); base += __popcll(m);
            if (kk[v] >= T && r < 16) { GT[h * 16 + r] = cd[v]; EX[h * 16 + r] = i1 * PEER_K + TI[(h * 2 + 1) * 16 + jb + v]; } }
    }
    LDS_WAIT();
#pragma unroll
    for (int ps = 0; ps < 2; ++ps) { const int idx = ps * 64 + lane; const float v = GT[idx];
        float mx = v; mx = fmaxf(mx, dpp_xor1(mx)); mx = fmaxf(mx, dpp_xor2(mx)); mx = fmaxf(mx, __shfl_xor(mx, 4)); mx = fmaxf(mx, __shfl_xor(mx, 8));
        const float e = __expf(v - mx); float sm = e; sm += dpp_xor1(sm); sm += dpp_xor2(sm); sm += __shfl_xor(sm, 4); sm += __shfl_xor(sm, 8);
        LDS_WAIT(); GT[idx] = e / sm; }
    LDS_WAIT();
}
__device__ __forceinline__ void peer_gather(const Ptrs& P, int tok, const LAS int* EX, const LAS float* GT, const LAS int* EXN, bool first, u32x4 (&R)[8][2], unsigned (&SCW)[8], int lane) {
    const bf16* HN2 = (const bf16*)(P.ws + WS_HN) + (size_t)tok * DM; const unsigned char* E4 = P.ws + WS_E4;
    float rs_tok; { const f32x4* p = (const f32x4*)((const float*)(P.ws + WS_PSS) + (size_t)tok * 16); const f32x4 a = (p[0] + p[1]) + (p[2] + p[3]); rs_tok = 1.0f / sqrtf(((a[0] + a[1]) + (a[2] + a[3])) * (1.f / DM) + EPS); }
    float* orow = P.out + (size_t)tok * DM;
    int xq[2][4], xr[2][4]; float sx[2];
    u32x4 xa[2][4];
#pragma unroll
    for (int c = 0; c < 2; ++c)
#pragma unroll
        for (int q = 0; q < 4; ++q) xa[c][q] = *((const u32x4*)HN2 + 256 * c + 4 * lane + q);
#pragma unroll
    for (int c = 0; c < 2; ++c) { float xf[32];
#pragma unroll
        for (int q = 0; q < 4; ++q) { const u32x4 a = xa[c][q];
            xf[8 * q + 0] = bflo(a.x); xf[8 * q + 1] = bfhi(a.x); xf[8 * q + 2] = bflo(a.y); xf[8 * q + 3] = bfhi(a.y); xf[8 * q + 4] = bflo(a.z); xf[8 * q + 5] = bfhi(a.z); xf[8 * q + 6] = bflo(a.w); xf[8 * q + 7] = bfhi(a.w); }
        float am = 0.f;
#pragma unroll
        for (int i = 0; i < 32; ++i) am = fmaxf(am, fabsf(xf[i]));
        const float s_ = am > 0.f ? am * (1.0f / 7.0f) : 1.0f, inv = 1.0f / s_; sx[c] = s_ * rs_tok;
#pragma unroll
        for (int d = 0; d < 4; ++d) { unsigned wq = 0u, wr = 0u;
#pragma unroll
            for (int n = 0; n < 8; ++n) { const float t_ = xf[8 * d + n] * inv, q1 = fminf(fmaxf(rintf(t_), -7.f), 7.f); const int qv = (int)q1, rv = (int)fminf(fmaxf(rintf((t_ - q1) * 14.0f), -7.f), 7.f);
                wq |= ((unsigned)qv & 15u) << (4 * n); wr |= ((unsigned)rv & 15u) << (4 * n); }
            xq[c][d] = (int)wq; xr[c][d] = (int)wr; }
        asm volatile("" : "+v"(xq[c][0]), "+v"(xq[c][1]), "+v"(xq[c][2]), "+v"(xq[c][3]), "+v"(xr[c][0]), "+v"(xr[c][1]), "+v"(xr[c][2]), "+v"(xr[c][3]), "+v"(sx[c])); __builtin_amdgcn_sched_barrier(0); }
    float yoff[2] = {0.f, 0.f};
    f32x2 y[2][16];
#pragma unroll
    for (int c = 0; c < 2; ++c)
#pragma unroll
        for (int e = 0; e < 16; ++e) y[c][e] = (f32x2){0.f, 0.f};
    const int klane = 8 * ((lane >> 5) & 1) + 4 * ((lane >> 4) & 1) + 2 * ((lane >> 3) & 1) + ((lane >> 2) & 1);
    const unsigned lane16u = (unsigned)lane * 16u, lane4u = (unsigned)(lane >> 1) * 4u;
#define PEER_ISSUE(slot, tab, e_) do { const unsigned ri_ = (unsigned)(tab) * PEER_N + (unsigned)(e_);        \
        const GAS unsigned char* rb_ = (const GAS unsigned char*)E4 + (size_t)ri_ * E4ROW;        \
        R[slot][0] = *(const GAS u32x4*)(rb_ + lane16u); R[slot][1] = *(const GAS u32x4*)(rb_ + lane16u + 1024u); SCW[slot] = *(const GAS unsigned*)(rb_ + 2048u + lane4u); } while (0)
    int ex[16], exn[7];
#pragma unroll
    for (int k = 0; k < 16; ++k) ex[k] = __builtin_amdgcn_readfirstlane(EX[k]);
    if (first) { PEER_ISSUE(0, 0, ex[0]); PEER_ISSUE(1, 0, ex[1]); PEER_ISSUE(2, 0, ex[2]); PEER_ISSUE(3, 0, ex[3]); PEER_ISSUE(4, 0, ex[4]); PEER_ISSUE(5, 0, ex[5]); PEER_ISSUE(6, 0, ex[6]); }
    for (int h = 0; h < PEER_H; ++h) {
        const int hn = (h + 1 < PEER_H) ? h + 1 : h;
#pragma unroll
        for (int k = 0; k < 7; ++k) exn[k] = __builtin_amdgcn_readfirstlane((h + 1 < PEER_H) ? EX[hn * 16 + k] : EXN[k]);
        float part[16]; float w = 0.f;
#define PEER_PIN8(c, o) asm volatile("" : "+v"(y[c][o + 0]), "+v"(y[c][o + 1]), "+v"(y[c][o + 2]), "+v"(y[c][o + 3]), "+v"(y[c][o + 4]), "+v"(y[c][o + 5]), "+v"(y[c][o + 6]), "+v"(y[c][o + 7]))
#define PEER_PIN_Y() do { PEER_PIN8(0, 0); PEER_PIN8(0, 8); PEER_PIN8(1, 0); PEER_PIN8(1, 8); } while (0)
#define PEER_RED16() do { float p8[8], p4[4], p2[2], p1; \
            { const bool hb = (lane & 32) != 0; _Pragma("unroll") for (int i = 0; i < 8; ++i) { const float send = hb ? part[i] : part[i + 8], keep = hb ? part[i + 8] : part[i]; p8[i] = keep + __shfl_xor(send, 32); } } \
            { const bool hb = (lane & 16) != 0; _Pragma("unroll") for (int i = 0; i < 4; ++i) { const float send = hb ? p8[i] : p8[i + 4], keep = hb ? p8[i + 4] : p8[i]; p4[i] = keep + __shfl_xor(send, 16); } } \
            { const bool hb = (lane & 8) != 0; _Pragma("unroll") for (int i = 0; i < 2; ++i) { const float send = hb ? p4[i] : p4[i + 2], keep = hb ? p4[i + 2] : p4[i]; p2[i] = keep + __shfl_xor(send, 8); } } \
            { const bool hb = (lane & 4) != 0; const float send = hb ? p2[0] : p2[1], keep = hb ? p2[1] : p2[0]; p1 = keep + __shfl_xor(send, 4); } \
            p1 += dpp_xor2(p1); p1 += dpp_xor1(p1); w = GT[h * 16 + klane] * gelu_tanh(p1); } while (0)
#define PEER_PREF(s) do { constexpr int sn = (s) + 7, slotn = sn & 7; \
            if (sn < 16) PEER_ISSUE(slotn, 0, ex[sn < 16 ? sn : 0]); else if (sn < 32) PEER_ISSUE(slotn, 1, ex[(sn >= 16 && sn < 32) ? sn - 16 : 0]); else PEER_ISSUE(slotn, 0, exn[sn >= 32 ? sn - 32 : 0]); } while (0)
#define PEER_VACC(bb) do { y[c][4 * d + (bb)] = __builtin_elementwise_fma((f32x2){(float)((lo_ >> (8 * (bb))) & 0xffu), (float)((hi_ >> (8 * (bb))) & 0xffu)}, wc2[c], y[c][4 * d + (bb)]); } while (0)
#define PEER_USTEP(s) do { PEER_PREF(s); __builtin_amdgcn_sched_barrier(0); \
            { constexpr int slot = (s) & 7; float fa[2]; \
              _Pragma("unroll") for (int c = 0; c < 2; ++c) { int a_ = 0, b_ = 0; \
                _Pragma("unroll") for (int d = 0; d < 4; ++d) { a_ = __builtin_amdgcn_sdot8((int)R[slot][c][d], xq[c][d], a_, false); b_ = __builtin_amdgcn_sdot8((int)R[slot][c][d], xr[c][d], b_, false); } \
                fa[c] = fmaf((float)b_, 1.0f / 14.0f, (float)a_); } \
              part[s] = fmaf(fa[0], bflo(SCW[slot]) * sx[0], fa[1] * (bfhi(SCW[slot]) * sx[1])); asm volatile("" : "+v"(part[s])); } \
            __builtin_amdgcn_sched_barrier(0); } while (0)
#define PEER_VSTEP(s) do { PEER_PREF(s); __builtin_amdgcn_sched_barrier(0); \
            { constexpr int slot = (s) & 7, k = (s) - 16, lk = 32 * ((k >> 3) & 1) + 16 * ((k >> 2) & 1) + 8 * ((k >> 1) & 1) + 4 * (k & 1); \
              const float wk = __builtin_bit_cast(float, __builtin_amdgcn_readlane(__builtin_bit_cast(int, w), lk)); \
              const float wc[2] = {wk * bflo(SCW[slot]), wk * bfhi(SCW[slot])}; yoff[0] = fmaf(8.0f, wc[0], yoff[0]); yoff[1] = fmaf(8.0f, wc[1], yoff[1]); \
              const f32x2 wc2[2] = {(f32x2){wc[0], wc[0]}, (f32x2){wc[1], wc[1]}}; \
              _Pragma("unroll") for (int c = 0; c < 2; ++c) { _Pragma("unroll") for (int d = 0; d < 4; ++d) { unsigned rw_ = R[slot][c][d]; asm volatile("" : "+v"(rw_));        \
                  unsigned lo_ = rw_ & 0x0F0F0F0Fu, hi_ = (rw_ >> 4) & 0x0F0F0F0Fu; asm volatile("" : "+v"(lo_), "+v"(hi_)); \
                  PEER_VACC(0); PEER_VACC(1); PEER_VACC(2); PEER_VACC(3); \
                  asm volatile("" : "+v"(y[c][4 * d]), "+v"(y[c][4 * d + 1]), "+v"(y[c][4 * d + 2]), "+v"(y[c][4 * d + 3])); \
                  __builtin_amdgcn_sched_barrier(0); } } } \
            PEER_PIN_Y(); __builtin_amdgcn_sched_barrier(0); } while (0)
        PEER_USTEP(0); PEER_USTEP(1); PEER_USTEP(2); PEER_USTEP(3); PEER_USTEP(4); PEER_USTEP(5); PEER_USTEP(6); PEER_USTEP(7);
        PEER_USTEP(8); PEER_USTEP(9); PEER_USTEP(10); PEER_USTEP(11); PEER_USTEP(12); PEER_USTEP(13); PEER_USTEP(14); PEER_USTEP(15);
        PEER_RED16();
        PEER_VSTEP(16); PEER_VSTEP(17); PEER_VSTEP(18); PEER_VSTEP(19); PEER_VSTEP(20); PEER_VSTEP(21); PEER_VSTEP(22); PEER_VSTEP(23);
        PEER_VSTEP(24); PEER_VSTEP(25); PEER_VSTEP(26); PEER_VSTEP(27); PEER_VSTEP(28); PEER_VSTEP(29); PEER_VSTEP(30); PEER_VSTEP(31);
#undef PEER_USTEP
#undef PEER_VSTEP
#undef PEER_PREF
#undef PEER_VACC
#undef PEER_RED16
#undef PEER_PIN_Y
#undef PEER_PIN8
#pragma unroll
        for (int k = 0; k < 16; ++k) ex[k] = __builtin_amdgcn_readfirstlane(EX[hn * 16 + k]);
    }
#undef PEER_ISSUE
#pragma unroll
    for (int c = 0; c < 2; ++c) { f32x4* o = (f32x4*)(orow + 2048 * c + 32 * lane);
#pragma unroll
        for (int q = 0; q < 4; ++q) { const u32x4 a = *((const u32x4*)HN2 + 256 * c + 4 * lane + q);
            o[2 * q] = (f32x4){bflo(a.x), bfhi(a.x), bflo(a.y), bfhi(a.y)} + ((f32x4){y[c][4 * q][0], y[c][4 * q][1], y[c][4 * q + 1][0], y[c][4 * q + 1][1]} - yoff[c]);
            o[2 * q + 1] = (f32x4){bflo(a.z), bfhi(a.z), bflo(a.w), bfhi(a.w)} + ((f32x4){y[c][4 * q + 2][0], y[c][4 * q + 2][1], y[c][4 * q + 3][0], y[c][4 * q + 3][1]} - yoff[c]); } }
    LDS_WAIT();
}

__device__ __forceinline__ unsigned enc_e4m3(float x) {
    const unsigned u = __builtin_bit_cast(unsigned, x), sign = (u >> 24) & 0x80u; const float ax = fabsf(x);
    unsigned code;
    if (ax < 0.015625f) code = (unsigned)rintf(ax * 512.0f);
    else { unsigned a = __builtin_bit_cast(unsigned, ax); a += 0x7FFFFu + ((a >> 20) & 1u); code = ((((a >> 23) - 120u) << 3) | ((a >> 20) & 7u)); }
    return sign | code;
}
constexpr int LDS_BYTES = 147456, MISC_OFF = LDS_BYTES - 256;
constexpr int CW_BAR = 1024;
static_assert((CW_BAR + XCD_BAR_WORDS) * 4 <= (int)CTL_ZERO_BYTES, "ctl");

typedef const __attribute__((address_space(4))) Ptrs* KargPtr;
__device__ __forceinline__ Ptrs load_args() {
    typedef const __attribute__((address_space(4))) unsigned long long* KW;
    Ptrs r;
#if defined(__HIP_DEVICE_COMPILE__)
    KW kp = (KW)__builtin_amdgcn_kernarg_segment_ptr(); asm volatile("" : "+s"(kp));
#define LDF(field, idx) r.field = (decltype(r.field))(GAS void*)kp[idx]
    LDF(x, 0); LDF(meta, 1); LDF(norm1_g, 2); LDF(w_in, 3); LDF(b_forget, 4); LDF(q_norm_g, 5); LDF(k_norm_g, 6); LDF(lam_re, 7); LDF(lam_im, 8); LDF(log_dt, 9);
    LDF(b_re, 10); LDF(b_im, 11); LDF(c_re, 12); LDF(c_im, 13); LDF(d_skip, 14); LDF(w_glu, 15); LDF(w_br_attn, 16); LDF(w_br_ssm, 17); LDF(w_out, 18); LDF(norm2_g, 19);
    LDF(w_query, 20); LDF(sub_keys, 21); LDF(expert_u, 22); LDF(expert_v, 23); LDF(out, 24); LDF(ws, 25);
#undef LDF
#endif
    return r;
}
__device__ __forceinline__ int fresh_lane() { int l = (int)__builtin_amdgcn_mbcnt_hi(~0u, __builtin_amdgcn_mbcnt_lo(~0u, 0u)); asm volatile("" : "+v"(l)); return l; }

__global__ void __launch_bounds__(512, 2) mega_fwd(Ptrs Punused) {
    extern __shared__ __attribute__((aligned(16))) unsigned char lds_raw[];
    LAS unsigned char* lds = (LAS unsigned char*)lds_raw;
    const int tid = threadIdx.x, wave = __builtin_amdgcn_readfirstlane(tid >> 6);
    const int G = gridDim.x, bx = blockIdx.x, vcu = (G % 8 == 0) ? (bx % 8) * (G / 8) + bx / 8 : bx;
    const int gw = bx * 8 + wave, NGW = G * 8;
    volatile LAS unsigned* MISC = (volatile LAS unsigned*)(lds + MISC_OFF);
    if (tid < 64) MISC[tid] = 0u;
    __syncthreads();
    XcdBarrier bar;
    { const Ptrs P = load_args(); bar = xcd_barrier_post((unsigned*)(P.ws + WS_CTL) + CW_BAR, MISC + 8); }

    { const Ptrs P = load_args(); const int lane = fresh_lane(); unsigned char* ws = P.ws;
      p0_prologue(P, lds, gw, NGW, wave, lane);
      if (gw < NG) s5_tables(P, gw, lane);
      f32x4 g1v[16];
#pragma unroll
      for (int j = 0; j < 16; ++j) g1v[j] = ((const f32x4*)P.norm1_g)[lane + 64 * j];
      { f32x4 va[16], vb[16];
#define RMS1_SRC(r) ((r) < NTOK ? P.x + (size_t)(r) * DM : P.meta + (size_t)((r) - NTOK) * DM)
#define RMS1_PROC(v, r) rms_row_proc(v, g1v, (bf16*)(ws + WS_HN) + (size_t)(r) * DM, lane, (r) < NTOK ? ws + WS_A8 + (size_t)(r) * DM : nullptr, (float*)(ws + WS_SA) + (r))
        int r = gw;
        if (r < NROWS) rms_row_load(va, RMS1_SRC(r), lane);
        for (; r < NROWS; r += 2 * NGW) {
            const int r1 = r + NGW, r2 = r + 2 * NGW;
            if (r1 < NROWS) rms_row_load(vb, RMS1_SRC(r1), lane);
            __builtin_amdgcn_sched_barrier(0);
            RMS1_PROC(va, r);
            __builtin_amdgcn_sched_barrier(0);
            if (r1 < NROWS) { if (r2 < NROWS) rms_row_load(va, RMS1_SRC(r2), lane); __builtin_amdgcn_sched_barrier(0); RMS1_PROC(vb, r1); __builtin_amdgcn_sched_barrier(0); }
        }
#undef RMS1_SRC
#undef RMS1_PROC
      }
      { unsigned* cmax = (unsigned*)(ws + WS_CTL) + CW_CMAX;
        for (int t = gw; t < 64 * 64; t += NGW) { const int kt = t >> 6, ct = t & 63; const float* wp = P.w_in + (size_t)(kt * 64) * NCOLS_SRC + ct * 256 + (ct >= 24 ? 16 : 0) + 4 * lane;
            f32x4 m4 = (f32x4){0.f, 0.f, 0.f, 0.f};
#pragma unroll 8
            for (int k = 0; k < 64; ++k) { const f32x4 w = *(const f32x4*)(wp + (size_t)k * NCOLS_SRC); m4[0] = fmaxf(m4[0], fabsf(w[0])); m4[1] = fmaxf(m4[1], fabsf(w[1])); m4[2] = fmaxf(m4[2], fabsf(w[2])); m4[3] = fmaxf(m4[3], fabsf(w[3])); }
#pragma unroll
            for (int e = 0; e < 4; ++e) atomicMax(cmax + ct * 256 + 4 * lane + e, __builtin_bit_cast(unsigned, m4[e])); }
        unsigned* cm2 = (unsigned*)(ws + WS_CTL) + CW_CMAX2;
        for (int t = gw; t < 2048; t += NGW) {
            if (t < 512) absmax_tile(P.w_br_attn + (t & 15) * 256, DM, (t >> 4) * 64, cm2 + (t & 15) * 256, lane);
            else if (t < 1024) absmax_tile(P.w_br_ssm + ((t - 512) & 15) * 256, DM, ((t - 512) >> 4) * 64, cm2 + 4096 + ((t - 512) & 15) * 256, lane);
            else absmax_tile(P.w_out + ((t - 1024) & 15) * 256, DM, ((t - 1024) >> 4) * 64, cm2 + 8192 + ((t - 1024) & 15) * 256, lane); } } }
    xcd_barrier(bar);

    { const Ptrs P = load_args(); const int lane = fresh_lane(); unsigned char* ws = P.ws;
      p1_prelude(P, gw, NGW, lane);
      { LAS float* scr = (LAS float*)(lds + wave * 16640); const unsigned* cmax = (const unsigned*)(ws + WS_CTL) + CW_CMAX;
        for (int t = gw; t < 64 * 256; t += NGW) tr_tile_i8(P.w_in, (t & 255) * 64, (t >> 8) * 64, ws + WS_W8, cmax, (float*)(ws + WS_SW), scr, lane);
        const unsigned* cm2 = (const unsigned*)(ws + WS_CTL) + CW_CMAX2; float* sw2 = (float*)(ws + WS_SW2);
        constexpr int NPRE = NROWS / 16 + (3 * 2048) / 16;
        const int nfree = NGW > NPRE ? NGW - NPRE : 0, nq8a = nfree * 8 < 8192 ? nfree * 8 : 8192;
        for (int j = 0; j < 8192; ++j) {
            int t;
            if (gw >= NPRE) { if (j >= 8) break; t = (gw - NPRE) * 8 + j; if (t >= nq8a) break; }
            else { t = nq8a + gw + j * (NGW < NPRE ? NGW : NPRE); if (t >= 8192) break; }
            if (t < 2048) tr_tile_q8(P.w_br_attn, DM, (t & 63) * 64, (t >> 6) * 64, ws + WS_WAB, DM, 0, (t & 63) * 64, cm2, sw2, scr, lane);
            else if (t < 4096) tr_tile_q8(P.w_br_ssm, DM, (t & 63) * 64, ((t - 2048) >> 6) * 64, ws + WS_WAB, DM, SSMW, (t & 63) * 64, cm2 + 4096, sw2 + 4096, scr, lane);
            else tr_tile_q8(P.w_out, DM, (t & 63) * 64, ((t - 4096) >> 6) * 64, ws + WS_WOUT, DM, 0, (t & 63) * 64, cm2 + 8192, sw2 + 8192, scr, lane); } } }
    xcd_barrier(bar);
    { const Ptrs P = load_args(); unsigned char* ws = P.ws;
      pg8::Gemm g{(const bf16*)(ws + WS_A8), (const bf16*)(ws + WS_W8), DM / 2, DM / 2, DM / 2}; pg8::StaticOrder S; S.init(NTOK, 16384, G, bx);
      Epi1 E{(bf16*)(ws + WS_Q), (bf16*)(ws + WS_K), (bf16*)(ws + WS_V), (bf16*)(ws + WS_U), (bf16*)(ws + WS_GA), (bf16*)(ws + WS_GB), (const float*)(ws + WS_SA), (const float*)(ws + WS_SW), P.q_norm_g, P.k_norm_g, (PG8_LAS float*)(lds + pg8::STAGE_BYTES)};
      pg8::gemm_phase<Epi1, pg8::StaticOrder, true, true>(lds, g, S, E); }
    xcd_barrier(bar);

    { const Ptrs P = load_args(); const int lane = fresh_lane();
      const int rgw = NGW - 1 - gw;
      if (rgw < NB * NH) p2_cumsum(P, rgw, lane);
      p2_qknorm_zero(P, rgw, NGW, lane);
      for (int u = gw; u < NB * NG * (NCH - 1); u += NGW) { const int ch = u % (NCH - 1), bg = u / (NCH - 1); s5_unit<false>(P, bg / NG, bg % NG, ch, (LAS float*)(lds + wave * 12800), (LAS unsigned*)(lds + wave * 12800 + 8448), lane); } }
    xcd_barrier(bar);

    { const Ptrs P = load_args(); attn_phase(P, (char*)lds_raw, vcu, G); }
    __syncthreads();
    { const Ptrs P = load_args(); const int lane = fresh_lane();
      for (int u = gw; u < NB * NG * NCH; u += NGW) { const int ch = u % NCH, bg = u / NCH;
        s5_unit<true>(P, bg / NG, bg % NG, ch, (LAS float*)(lds + wave * 12800), (LAS unsigned*)(lds + wave * 12800 + 8448), lane); } }
    xcd_barrier(bar);

    { const Ptrs P = load_args(); unsigned char* ws = P.ws;
      pg8::Gemm g{(const bf16*)(ws + WS_Z), (const bf16*)(ws + WS_WGLU), SSMW, SSMW, SSMW}; pg8::StaticOrder S; S.init(NTOK, SSMW, G, bx);
      EpiGlu E{(const bf16*)(ws + WS_Z), (bf16*)(ws + WS_AS)};
      pg8::gemm_phase<EpiGlu, pg8::StaticOrder, true>(lds, g, S, E); }
    xcd_barrier(bar);

    { const Ptrs P = load_args(); const int lane = fresh_lane(); unsigned char* ws = P.ws;
      { u32x4 ra[8], rb[8]; int r = gw;
        if (r < NTOK) rowq8_load(ra, (const bf16*)(ws + WS_AS) + (size_t)r * DM, lane);
        for (; r < NTOK; r += 2 * NGW) { const int r1 = r + NGW, r2 = r + 2 * NGW;
            if (r1 < NTOK) rowq8_load(rb, (const bf16*)(ws + WS_AS) + (size_t)r1 * DM, lane);
            __builtin_amdgcn_sched_barrier(0);
            rowq8<true>(ra, ws + WS_AS8 + (size_t)r * DM, (float*)(ws + WS_SA2) + r, lane);
            __builtin_amdgcn_sched_barrier(0);
            if (r1 < NTOK) { if (r2 < NTOK) rowq8_load(ra, (const bf16*)(ws + WS_AS) + (size_t)r2 * DM, lane); __builtin_amdgcn_sched_barrier(0);
                rowq8<true>(rb, ws + WS_AS8 + (size_t)r1 * DM, (float*)(ws + WS_SA2) + r1, lane); __builtin_amdgcn_sched_barrier(0); } } } }
    xcd_barrier(bar);

    { const Ptrs P = load_args(); unsigned char* ws = P.ws;
      pg8::Gemm g{(const bf16*)(ws + WS_AS8), (const bf16*)(ws + WS_WAB), DM / 2, DM / 2, ATTW / 2}; pg8::StaticOrder S; S.init(NTOK, DM, G, bx);
      EpiBrA E{(const bf16*)(ws + WS_GA), (bf16*)(ws + WS_HN), (const float*)(ws + WS_SA2), (const float*)(ws + WS_SW2)};
      pg8::gemm_phase<EpiBrA, pg8::StaticOrder, true, true>(lds, g, S, E); }
    asm volatile("s_waitcnt vmcnt(0)" ::: "memory"); __syncthreads();

    { const Ptrs P = load_args(); unsigned char* ws = P.ws;
      pg8::Gemm g{(const bf16*)(ws + WS_AS8 + SSMW), (const bf16*)(ws + WS_WAB + SSMW), DM / 2, DM / 2, SSMW / 2}; pg8::StaticOrder S; S.init(NTOK, DM, G, bx);
      EpiBrB E{(const bf16*)(ws + WS_GB), (const bf16*)(ws + WS_HN), (bf16*)(ws + WS_U), (const float*)(ws + WS_SA2) + NTOK, (const float*)(ws + WS_SW2) + 4096};
      pg8::gemm_phase<EpiBrB, pg8::StaticOrder, true, true>(lds, g, S, E); }
    xcd_barrier(bar);

    { const Ptrs P = load_args(); const int lane = fresh_lane(); unsigned char* ws = P.ws;
      { u32x4 ra[8], rb[8]; int r = gw;
        if (r < NTOK) rowq8_load(ra, (const bf16*)(ws + WS_U) + (size_t)r * DM, lane);
        for (; r < NTOK; r += 2 * NGW) { const int r1 = r + NGW, r2 = r + 2 * NGW;
            if (r1 < NTOK) rowq8_load(rb, (const bf16*)(ws + WS_U) + (size_t)r1 * DM, lane);
            __builtin_amdgcn_sched_barrier(0);
            rowq8<false>(ra, ws + WS_MIX8 + (size_t)r * DM, (float*)(ws + WS_SA2) + 2 * NTOK + r, lane);
            __builtin_amdgcn_sched_barrier(0);
            if (r1 < NTOK) { if (r2 < NTOK) rowq8_load(ra, (const bf16*)(ws + WS_U) + (size_t)r2 * DM, lane); __builtin_amdgcn_sched_barrier(0);
                rowq8<false>(rb, ws + WS_MIX8 + (size_t)r1 * DM, (float*)(ws + WS_SA2) + 2 * NTOK + r1, lane); __builtin_amdgcn_sched_barrier(0); } } }
      for (int row = gw; row < 2 * PEER_N; row += NGW) {
          const bool isv = row >= PEER_N;
          const float* src = !isv ? P.expert_u + (size_t)row * DM : P.expert_v + (size_t)(row - PEER_N) * DM;
          f32x4 v[16];
#pragma unroll
          for (int j = 0; j < 16; ++j) v[j] = ((const f32x4*)src)[lane + 64 * j];
          if (!isv) {
#pragma unroll
              for (int j = 0; j < 16; ++j) v[j] = v[j] * ((const f32x4*)P.norm2_g)[lane + 64 * j]; }
          unsigned short* dst = (unsigned short*)(ws + WS_E4 + (size_t)row * E4ROW) + lane;
          bf16* sdst = (bf16*)(ws + WS_E4 + (size_t)row * E4ROW + 2048);
          const int bias = isv ? 8 : 0;
          float amv[16];
#pragma unroll
          for (int j = 0; j < 16; ++j) { amv[j] = fmaxf(fmaxf(fabsf(v[j][0]), fabsf(v[j][1])), fmaxf(fabsf(v[j][2]), fabsf(v[j][3]))); amv[j] = fmaxf(amv[j], dpp_xor1(amv[j])); amv[j] = fmaxf(amv[j], dpp_xor2(amv[j])); }
#pragma unroll
          for (int j = 0; j < 16; ++j) amv[j] = fmaxf(amv[j], __shfl_xor(amv[j], 4));
#pragma unroll
          for (int j = 0; j < 16; ++j) amv[j] = fmaxf(amv[j], __shfl_xor(amv[j], 8));
#pragma unroll
          for (int j = 0; j < 16; ++j) {
              const float am = amv[j];
              const unsigned sb = am > 0.f ? f2bf(am * (1.0f / 7.0f)) : 0x3f80u;
              const float inv = 1.0f / __builtin_bit_cast(float, sb << 16);
              unsigned wv = 0u;
#pragma unroll
              for (int e = 0; e < 4; ++e) { const int qv = (int)fminf(fmaxf(rintf(v[j][e] * inv), -7.f), 7.f) + bias; wv |= ((unsigned)qv & 15u) << (4 * e); }
              dst[64 * j] = (unsigned short)wv;
              if ((lane & 15) == 0) { const int blk = 4 * j + (lane >> 4); sdst[(blk & 31) * 2 + (blk >> 5)] = (bf16)sb; }
          }
      } }
    xcd_barrier(bar);

    { const Ptrs P = load_args(); unsigned char* ws = P.ws;
      pg8::Gemm g{(const bf16*)(ws + WS_MIX8), (const bf16*)(ws + WS_WOUT), DM / 2, DM / 2, DM / 2}; pg8::StaticOrder S; S.init(NTOK, DM, G, bx);
      EpiOut E{P.x, (const float*)(ws + WS_SA2) + 2 * NTOK, (const float*)(ws + WS_SW2) + 8192, (bf16*)(ws + WS_HN), (float*)(ws + WS_PSS), (PG8_LAS float*)(lds + pg8::STAGE_BYTES)};
      pg8::gemm_phase<EpiOut, pg8::StaticOrder, true, true>(lds, g, S, E); }
    xcd_barrier(bar);

    { const Ptrs P = load_args(); unsigned char* ws = P.ws;
      pg8::Gemm g{(const bf16*)(ws + WS_HN), (const bf16*)(ws + WS_WQ), DM, DM, DM}; pg8::StaticOrder S; S.init(NTOK, PEER_QW, G, bx);
      EpiQP E{(float*)(ws + WS_GA), (const float*)(ws + WS_PSS)};
      pg8::gemm_phase<EpiQP, pg8::StaticOrder, true>(lds, g, S, E); }
    xcd_barrier(bar);

    { const Ptrs P = load_args(); const int lane = fresh_lane(); LAS unsigned char* wl = lds + wave * 12288;
      LAS float* TV = (LAS float*)wl; LAS int* TI = (LAS int*)(wl + 1024);
#define PEER_EXB(i) ((LAS int*)(wl + 2048 + (i) * 1024))
#define PEER_GTB(i) ((LAS float*)(wl + 2560 + (i) * 1024))
      u32x4 R[8][2]; unsigned SCW[8];
      int cur = 0; bool first = true;
      if (gw < NTOK) peer_select(P, gw, TV, TI, PEER_EXB(0), PEER_GTB(0), lane);
      for (int tok = gw; tok < NTOK; tok += NGW) { const int nxt = tok + NGW;
          if (nxt < NTOK) peer_select(P, nxt, TV, TI, PEER_EXB(cur ^ 1), PEER_GTB(cur ^ 1), lane);
          peer_gather(P, tok, PEER_EXB(cur), PEER_GTB(cur), nxt < NTOK ? PEER_EXB(cur ^ 1) : PEER_EXB(cur), first, R, SCW, lane);
          first = false; cur ^= 1; }
#undef PEER_EXB
#undef PEER_GTB
    }
}

extern "C" void kernel_launch(void* const* d_in, const int* in_sizes, int n_in, void* d_out, int out_size, void* d_ws, size_t ws_size, hipStream_t stream) {
    static int grid = 0;
    if (grid == 0) {
        if (n_in != 24 || out_size != NTOK * DM || ws_size < WS_END) { fprintf(stderr, "kernel_launch: unexpected shapes (n_in %d out %d ws %zu)\n", n_in, out_size, ws_size); grid = -1; return; }
        int dev = 0, cus = 0, per_cu = 0;
        if (hipGetDevice(&dev) != hipSuccess || hipDeviceGetAttribute(&cus, hipDeviceAttributeMultiprocessorCount, dev) != hipSuccess) { grid = -1; return; }
        if (hipFuncSetAttribute((const void*)mega_fwd, hipFuncAttributeMaxDynamicSharedMemorySize, LDS_BYTES) != hipSuccess) { grid = -1; return; }
        if (hipOccupancyMaxActiveBlocksPerMultiprocessor(&per_cu, (const void*)mega_fwd, 512, LDS_BYTES) != hipSuccess || per_cu < 1) fprintf(stderr, "kernel_launch: occupancy query says %d\n", per_cu);
        (void)hipGetLastError();
        grid = cus;
    }
    if (grid < 0) return;
    if (hipMemsetAsync((char*)d_ws + WS_CTL, 0, CTL_ZERO_BYTES, stream) != hipSuccess) return;
    Ptrs p{};
    const float** f = (const float**)&p;
    for (int i = 0; i < 24; ++i) f[i] = (const float*)d_in[i];
    p.out = (float*)d_out; p.ws = (unsigned char*)d_ws;
    hipLaunchKernelGGL(mega_fwd, dim3(grid), dim3(512), LDS_BYTES, stream, p);
}
```
